# Optimizing an MI355X kernel written in HIP

```python
import math
import jax
import jax.numpy as jnp
from jax import lax
import numpy as np

D_MODEL = 4096
BATCH = 1
SEQ = 8192
DEPTH = 1

DA_HEADS = 16
DA_HEAD_DIM = 128
DA_V_DIM = 2 * DA_HEAD_DIM
DA_WIDTH = DA_HEADS * DA_V_DIM
SG_WIDTH = 4096
SG_GROUPS = 16
SG_GROUP_DIM = SG_WIDTH // SG_GROUPS
CHUNK = 128
NUM_BUCKETS = 32
MAX_DISTANCE = 128
MEM_LEN = 256
XA_HEADS = 4
XA_HEAD_DIM = 128
XA_WIDTH = XA_HEADS * XA_HEAD_DIM
Q_BLOCK = 128
EPS = 1e-6
IN_SIZES = (DA_WIDTH, DA_WIDTH, DA_WIDTH, DA_WIDTH, SG_WIDTH, SG_WIDTH, SG_WIDTH, 2 * D_MODEL)
IN_WIDTH = 4 * DA_WIDTH + 3 * SG_WIDTH + 2 * D_MODEL

kernel_name = "hybrid_diffattn_chunk_sgu_block"


def _split_points(sizes):
    pts, acc = [], 0
    for s in sizes[:-1]:
        acc += s
        pts.append(acc)
    return pts


def rms_norm(x, g):
    xf = x.astype(jnp.float32)
    y = xf * lax.rsqrt(jnp.mean(xf * xf, axis=-1, keepdims=True) + EPS)
    return (y * g.astype(jnp.float32)).astype(x.dtype)


def layer_norm(x, g, b):
    xf = x.astype(jnp.float32)
    mu = jnp.mean(xf, axis=-1, keepdims=True)
    xc = xf - mu
    y = xc * lax.rsqrt(jnp.mean(xc * xc, axis=-1, keepdims=True) + EPS)
    return (y * g.astype(jnp.float32) + b.astype(jnp.float32)).astype(x.dtype)


def t5_bucket(rel):
    n = jnp.maximum(rel, 0)
    max_exact = NUM_BUCKETS // 2
    nf = jnp.maximum(n, 1).astype(jnp.float32)
    large = max_exact + (jnp.log(nf / max_exact) / math.log(MAX_DISTANCE / max_exact)
                         * (NUM_BUCKETS - max_exact)).astype(jnp.int32)
    large = jnp.minimum(large, NUM_BUCKETS - 1)
    return jnp.where(n < max_exact, n, large)


def diff_attention(q, k, v, positions, rel_bias, lam):
    B, S, H, _, Dh = q.shape
    nb = S // Q_BLOCK
    scale = Dh ** -0.5
    qb = q.reshape(B, nb, Q_BLOCK, H, 2, Dh).transpose(1, 0, 2, 3, 4, 5)
    pb = positions.reshape(B, nb, Q_BLOCK).transpose(1, 0, 2)

    def block(args):
        qi, pi = args
        s = jnp.einsum('bqhcd,bkhcd->bchqk', qi, k).astype(jnp.float32) * scale
        rel = pi[:, :, None] - positions[:, None, :]
        bias = rel_bias[t5_bucket(rel)]
        bias = bias.transpose(0, 3, 1, 2)[:, None].astype(jnp.float32)
        s = jnp.where((rel >= 0)[:, None, None], s + bias, -jnp.inf)
        p = jax.nn.softmax(s, axis=-1)
        a = p[:, 0] - lam * p[:, 1]
        return jnp.einsum('bhqk,bkhd->bqhd', a.astype(v.dtype), v)

    o = lax.map(block, (qb, pb))
    return o.transpose(1, 0, 2, 3, 4).reshape(B, S, H, v.shape[-1])


def chunk_spatial_gate(u, v, w_s, b_s, ln_g, ln_b):
    B, S, _ = v.shape
    v = layer_norm(v, ln_g, ln_b)
    vc = v.reshape(B, S // CHUNK, CHUNK, SG_GROUPS, SG_GROUP_DIM)
    mask = jnp.tril(jnp.ones((CHUNK, CHUNK), dtype=bool))
    w = jnp.where(mask[None], w_s, jnp.zeros_like(w_s))
    mixed = jnp.einsum('gts,bnsgd->bntgd', w, vc) + b_s.T[None, None, :, :, None]
    return u * mixed.reshape(B, S, SG_WIDTH)


def memory_cross_attention(h, mem, w_xq, w_xkv, w_xo):
    B, S, _ = h.shape
    q = (h @ w_xq).reshape(B, S, XA_HEADS, XA_HEAD_DIM)
    kv = (mem @ w_xkv).reshape(B, MEM_LEN, 2, XA_HEADS, XA_HEAD_DIM)
    k, v = kv[:, :, 0], kv[:, :, 1]
    s = jnp.einsum('bqhd,bkhd->bhqk', q, k).astype(jnp.float32) * (XA_HEAD_DIM ** -0.5)
    p = jax.nn.softmax(s, axis=-1).astype(v.dtype)
    o = jnp.einsum('bhqk,bkhd->bqhd', p, v).reshape(B, S, XA_WIDTH)
    return o @ w_xo


def setup_inputs(seed: int = 0) -> dict:
    key = jax.random.key(seed)
    ks = jax.random.split(key, 26)
    f = jnp.float32

    def nrm(k, shape, scale):
        return jax.random.normal(k, shape, f) * scale

    x = nrm(ks[0], (BATCH, SEQ, D_MODEL), 1.0)
    start = jax.random.randint(ks[1], (BATCH, 1), 0, 4096, dtype=jnp.int32)
    positions = start + jnp.arange(SEQ, dtype=jnp.int32)[None, :]
    mem = nrm(ks[2], (BATCH, MEM_LEN, D_MODEL), 1.0)
    return {
        "x": x,
        "positions": positions,
        "mem": mem,
        "w_in": nrm(ks[3], (DEPTH, D_MODEL, IN_WIDTH), D_MODEL ** -0.5),
        "b_gate": nrm(ks[4], (DEPTH, 2 * D_MODEL), 0.1),
        "norm1_g": 1.0 + nrm(ks[5], (DEPTH, D_MODEL), 0.02),
        "lam_q1": nrm(ks[6], (DEPTH, DA_HEAD_DIM), 0.1),
        "lam_k1": nrm(ks[7], (DEPTH, DA_HEAD_DIM), 0.1),
        "lam_q2": nrm(ks[8], (DEPTH, DA_HEAD_DIM), 0.1),
        "lam_k2": nrm(ks[9], (DEPTH, DA_HEAD_DIM), 0.1),
        "subln_g": 1.0 + nrm(ks[10], (DEPTH, DA_V_DIM), 0.02),
        "rel_bias": nrm(ks[11], (NUM_BUCKETS, DA_HEADS), 0.5),
        "sg_ln_g": 1.0 + nrm(ks[12], (DEPTH, SG_WIDTH), 0.02),
        "sg_ln_b": nrm(ks[13], (DEPTH, SG_WIDTH), 0.02),
        "sg_w": nrm(ks[14], (DEPTH, SG_GROUPS, CHUNK, CHUNK), CHUNK ** -0.5),
        "sg_b": 1.0 + nrm(ks[15], (DEPTH, SG_GROUPS, CHUNK), 0.1),
        "w_proj_a": nrm(ks[16], (DEPTH, DA_WIDTH, D_MODEL), DA_WIDTH ** -0.5),
        "w_proj_b": nrm(ks[17], (DEPTH, SG_WIDTH, D_MODEL), SG_WIDTH ** -0.5),
        "w_out": nrm(ks[18], (DEPTH, D_MODEL, D_MODEL), D_MODEL ** -0.5),
        "norm_x_g": 1.0 + nrm(ks[19], (DEPTH, D_MODEL), 0.02),
        "norm_mem_g": 1.0 + nrm(ks[20], (DEPTH, D_MODEL), 0.02),
        "w_xq": nrm(ks[21], (DEPTH, D_MODEL, XA_WIDTH), D_MODEL ** -0.5),
        "w_xkv": nrm(ks[22], (DEPTH, D_MODEL, 2 * XA_WIDTH), D_MODEL ** -0.5),
        "w_xo": nrm(ks[23], (DEPTH, XA_WIDTH, D_MODEL), XA_WIDTH ** -0.5),
        "final_g": 1.0 + nrm(ks[24], (D_MODEL,), 0.02),
    }


def reference(x, positions, mem, w_in, b_gate, norm1_g, lam_q1, lam_k1, lam_q2, lam_k2,
              subln_g, rel_bias, sg_ln_g, sg_ln_b, sg_w, sg_b, w_proj_a, w_proj_b, w_out,
              norm_x_g, norm_mem_g, w_xq, w_xkv, w_xo, final_g):
    B, S, _ = x.shape
    f32 = jnp.float32
    h = x
    for l in range(DEPTH):
        lam_init = 0.8 - 0.6 * math.exp(-0.3 * l)
        hn = rms_norm(h, norm1_g[l])
        proj = hn @ w_in[l]
        q_a, k_a, v_a, z_a, u_b, v_b, z_b, g_pre = jnp.split(proj, _split_points(IN_SIZES), axis=-1)
        lam = (jnp.exp(jnp.sum(lam_q1[l].astype(f32) * lam_k1[l].astype(f32)))
               - jnp.exp(jnp.sum(lam_q2[l].astype(f32) * lam_k2[l].astype(f32))) + lam_init)
        q_a = q_a.reshape(B, S, DA_HEADS, 2, DA_HEAD_DIM)
        k_a = k_a.reshape(B, S, DA_HEADS, 2, DA_HEAD_DIM)
        v_a = v_a.reshape(B, S, DA_HEADS, DA_V_DIM)
        o_a = diff_attention(q_a, k_a, v_a, positions, rel_bias, lam)
        o_a = (rms_norm(o_a, subln_g[l]) * (1.0 - lam_init)).reshape(B, S, DA_WIDTH)
        y_a = (o_a * jax.nn.silu(z_a)) @ w_proj_a[l]
        o_b = chunk_spatial_gate(jax.nn.gelu(u_b), jax.nn.gelu(v_b), sg_w[l], sg_b[l],
                                 sg_ln_g[l], sg_ln_b[l])
        y_b = (o_b * jax.nn.silu(z_b)) @ w_proj_b[l]
        g = jax.nn.sigmoid(g_pre + b_gate[l])
        g_a, g_b = g[..., :D_MODEL], g[..., D_MODEL:]
        h = h + (g_a * y_a + g_b * y_b) @ w_out[l]
        hn = rms_norm(h, norm_x_g[l])
        mn = rms_norm(mem, norm_mem_g[l])
        h = h + memory_cross_attention(hn, mn, w_xq[l], w_xkv[l], w_xo[l])
    return rms_norm(h, final_g)
```

```cpp
#include <hip/hip_runtime.h>
#include <hip/hip_cooperative_groups.h>
#include <cstdio>
#include <cstdint>
#include <cmath>
namespace pg8 {
#define PG8_LAS __attribute__((address_space(3)))
typedef unsigned short bf16_t;
typedef short bf16x8 __attribute__((ext_vector_type(8)));
typedef float f32x4 __attribute__((ext_vector_type(4)));
typedef unsigned u32x4 __attribute__((ext_vector_type(4)));
constexpr int BM = 256, BK = 64, HALF = 128, HTB = HALF * BK * 2  , STAGE_BYTES = 8 * HTB, NXCD = 8, WGM = 8;

__host__ __device__ __forceinline__ int lds_byte(int r, int c) { const int st = (r >> 4) * 2 + (c >> 5), rr = r & 15, cc = c & 31, ob = rr * 64 + cc * 2; return st * 1024 + (ob ^ (((ob >> 9) & 1) << 5)); }
__host__ __device__ __forceinline__ void stage_rc(int b, int& R, int& C) { const int st = b / 1024, sb = b % 1024, swz = sb ^ (((sb >> 9) & 1) << 5); R = (st >> 1) * 16 + swz / 64; C = (st & 1) * 32 + (swz % 64) / 2; }
__host__ __device__ __forceinline__ int perm32(int rho) { const int n = rho >> 4, i = rho & 15; return 8 * (i >> 2) + 4 * n + (i & 3); }

struct Unit { int pm, pn; };
struct Gemm { const bf16_t* A; const bf16_t* Bt; int M, N, K; int ld; };

struct StaticOrder {
    int nM, nN, nwg, G, c;
    __host__ __device__ void init(int M, int N, int G_, int c_) { nM = M / BM; nN = N / BM; nwg = nM * nN; G = G_; c = c_; }
    __host__ __device__ bool next(int i, Unit& u) const {
        const long L = (long)i * G + c; if (L >= nwg) return false;
        int wgid = (int)L; { const int q = nwg / NXCD, r = nwg % NXCD, xcd = wgid % NXCD, off = wgid / NXCD; wgid = (xcd < r ? xcd * (q + 1) : r * (q + 1) + (xcd - r) * q) + off; }
        const int nig = WGM * nN, gid = wgid / nig, fm = gid * WGM, gsz = (nM - fm) < WGM ? (nM - fm) : WGM;
        u.pm = fm + ((wgid % nig) % gsz); u.pn = (wgid % nig) / gsz; return true;
    }
    __device__ __forceinline__ void a_ready(const Unit&) const {}
    __device__ __forceinline__ void done(const Unit&) const {}
};

__device__ __forceinline__ unsigned cvt_pk_bf16(float lo, float hi) { unsigned r; asm volatile("v_cvt_pk_bf16_f32 %0, %1, %2" : "=v"(r) : "v"(lo), "v"(hi)); return r; }
typedef float f32x2 __attribute__((ext_vector_type(2)));
__device__ __forceinline__ float ex2_(float x) { return __builtin_amdgcn_exp2f(x); }
__device__ __forceinline__ float rcp_(float x) { return __builtin_amdgcn_rcpf(x); }
__device__ __forceinline__ float sigm_(float x) { return rcp_(1.f + ex2_(-1.4426950408889634f * x)); }
__device__ __forceinline__ float silu_(float x) { return x * sigm_(x); }
__device__ __forceinline__ float gelut_(float x) { const float u = 0.7978845608028654f * (x + 0.044715f * x * x * x); return x * sigm_(2.f * u); }
__device__ __forceinline__ float bf2f_(unsigned b) { return __uint_as_float(b << 16); }
template <int MODE> __device__ __forceinline__ float act_(float v, float sc) {
    if (MODE == 1) return v * sc; if (MODE == 2) return silu_(v); if (MODE == 3) return gelut_(v); if (MODE == 4) return sigm_(v); return v; }

struct EpiProj {
    static constexpr bool PERM = true, AFTER_DRAIN = false;
    bf16_t* O; int ldc; const float* bgate; float qscale; int plain;
    template <int MODE> __device__ __forceinline__ void run(const f32x4 (&acc)[2][2][4][2], const Unit& u, int wr, int wc, int fr, int fq) const {
        const int row0 = u.pm * BM + wr * 64 + fr, col0 = u.pn * BM + wc * 32 + 8 * fq;
        f32x4 bv[2][2];
#pragma unroll
        for (int bj = 0; bj < 2; ++bj)
#pragma unroll
            for (int n = 0; n < 2; ++n) bv[bj][n] = (MODE == 4) ? *(const f32x4*)(bgate + (col0 - 28672) + bj * HALF + 4 * n) : (f32x4){0.f, 0.f, 0.f, 0.f};
#pragma unroll
        for (int ai = 0; ai < 2; ++ai)
#pragma unroll
            for (int m = 0; m < 4; ++m) { bf16_t* rowp = O + (size_t)(row0 + ai * HALF + m * 16) * ldc + col0;
#pragma unroll
                for (int bj = 0; bj < 2; ++bj) { f32x4 v0 = acc[ai][bj][m][0] + bv[bj][0], v1 = acc[ai][bj][m][1] + bv[bj][1];
#pragma unroll
                    for (int e = 0; e < 4; ++e) { v0[e] = act_<MODE>(v0[e], qscale); v1[e] = act_<MODE>(v1[e], qscale); }
                    u32x4 w; w.x = cvt_pk_bf16(v0[0], v0[1]); w.y = cvt_pk_bf16(v0[2], v0[3]); w.z = cvt_pk_bf16(v1[0], v1[1]); w.w = cvt_pk_bf16(v1[2], v1[3]);
                    *(u32x4*)(rowp + bj * HALF) = w; } }
    }
    __device__ __forceinline__ void operator()(const f32x4 (&acc)[2][2][4][2], const Unit& u, int wr, int wc, int fr, int fq) const {
        const int sect = u.pn >> 4;
        if (plain || sect == 1 || sect == 2 || sect >= 7) run<0>(acc, u, wr, wc, fr, fq);
        else if (sect == 0) run<1>(acc, u, wr, wc, fr, fq);
        else if (sect == 3 || sect == 6) run<2>(acc, u, wr, wc, fr, fq);
        else if (sect == 4 || sect == 5) run<3>(acc, u, wr, wc, fr, fq);
        else run<4>(acc, u, wr, wc, fr, fq);
    }
};
struct EpiGateA {
    static constexpr bool PERM = true, AFTER_DRAIN = false;
    const bf16_t* G; int ldg; float* T; int ldt; const float* bg;
    __device__ __forceinline__ void operator()(const f32x4 (&acc)[2][2][4][2], const Unit& u, int wr, int wc, int fr, int fq) const {
        const int row0 = u.pm * BM + wr * 64 + fr, col0 = u.pn * BM + wc * 32 + 8 * fq;
#pragma unroll
        for (int ai = 0; ai < 2; ++ai)
#pragma unroll
            for (int m = 0; m < 4; ++m) { const size_t row = (size_t)(row0 + ai * HALF + m * 16);
#pragma unroll
                for (int bj = 0; bj < 2; ++bj) { const int col = col0 + bj * HALF; const u32x4 g = *(const u32x4*)(G + row * ldg + col);
                    f32x4 v0 = acc[ai][bj][m][0], v1 = acc[ai][bj][m][1];
                    const f32x4 b0 = *(const f32x4*)(bg + col), b1 = *(const f32x4*)(bg + col + 4);
                    v0[0] *= sigm_(bf2f_(g.x & 0xffffu) + b0[0]); v0[1] *= sigm_(bf2f_(g.x >> 16) + b0[1]); v0[2] *= sigm_(bf2f_(g.y & 0xffffu) + b0[2]); v0[3] *= sigm_(bf2f_(g.y >> 16) + b0[3]);
                    v1[0] *= sigm_(bf2f_(g.z & 0xffffu) + b1[0]); v1[1] *= sigm_(bf2f_(g.z >> 16) + b1[1]); v1[2] *= sigm_(bf2f_(g.w & 0xffffu) + b1[2]); v1[3] *= sigm_(bf2f_(g.w >> 16) + b1[3]);
                    *(f32x4*)(T + row * ldt + col) = v0; *(f32x4*)(T + row * ldt + col + 4) = v1; } }
    }
};
struct EpiGateB {
    static constexpr bool PERM = true, AFTER_DRAIN = false;
    const bf16_t* G; int ldg; const float* T; int ldt; bf16_t* O; int ldc; const float* bg;
    __device__ __forceinline__ void operator()(const f32x4 (&acc)[2][2][4][2], const Unit& u, int wr, int wc, int fr, int fq) const {
        const int row0 = u.pm * BM + wr * 64 + fr, col0 = u.pn * BM + wc * 32 + 8 * fq;
#pragma unroll
        for (int ai = 0; ai < 2; ++ai)
#pragma unroll
            for (int m = 0; m < 4; ++m) { const size_t row = (size_t)(row0 + ai * HALF + m * 16);
#pragma unroll
                for (int bj = 0; bj < 2; ++bj) { const int col = col0 + bj * HALF; const u32x4 g = *(const u32x4*)(G + row * ldg + col);
                    f32x4 v0 = acc[ai][bj][m][0], v1 = acc[ai][bj][m][1];
                    const f32x4 t0 = *(const f32x4*)(T + row * ldt + col), t1 = *(const f32x4*)(T + row * ldt + col + 4);
                    const f32x4 b0 = *(const f32x4*)(bg + col), b1 = *(const f32x4*)(bg + col + 4);
                    v0[0] = t0[0] + v0[0] * sigm_(bf2f_(g.x & 0xffffu) + b0[0]); v0[1] = t0[1] + v0[1] * sigm_(bf2f_(g.x >> 16) + b0[1]); v0[2] = t0[2] + v0[2] * sigm_(bf2f_(g.y & 0xffffu) + b0[2]); v0[3] = t0[3] + v0[3] * sigm_(bf2f_(g.y >> 16) + b0[3]);
                    v1[0] = t1[0] + v1[0] * sigm_(bf2f_(g.z & 0xffffu) + b1[0]); v1[1] = t1[1] + v1[1] * sigm_(bf2f_(g.z >> 16) + b1[1]); v1[2] = t1[2] + v1[2] * sigm_(bf2f_(g.w & 0xffffu) + b1[2]); v1[3] = t1[3] + v1[3] * sigm_(bf2f_(g.w >> 16) + b1[3]);
                    u32x4 w; w.x = cvt_pk_bf16(v0[0], v0[1]); w.y = cvt_pk_bf16(v0[2], v0[3]); w.z = cvt_pk_bf16(v1[0], v1[1]); w.w = cvt_pk_bf16(v1[2], v1[3]);
                    *(u32x4*)(O + row * ldc + col) = w; } }
    }
};
struct EpiRes {
    static constexpr bool PERM = true, AFTER_DRAIN = false;
    const float* X; float* H; int ld; const float* gx; bf16_t* HG; float* RS;
    __device__ __forceinline__ void operator()(const f32x4 (&acc)[2][2][4][2], const Unit& u, int wr, int wc, int fr, int fq) const {
        const int row0 = u.pm * BM + wr * 64 + fr, col0 = u.pn * BM + wc * 32 + 8 * fq;
#pragma unroll
        for (int ai = 0; ai < 2; ++ai)
#pragma unroll
            for (int m = 0; m < 4; ++m) { const size_t row = (size_t)(row0 + ai * HALF + m * 16); float ss = 0.f;
#pragma unroll
                for (int bj = 0; bj < 2; ++bj) { const int col = col0 + bj * HALF;
                    const f32x4 h0 = *(const f32x4*)(X + row * ld + col) + acc[ai][bj][m][0], h1 = *(const f32x4*)(X + row * ld + col + 4) + acc[ai][bj][m][1];
                    *(f32x4*)(H + row * ld + col) = h0; *(f32x4*)(H + row * ld + col + 4) = h1;
                    ss += (h0[0] * h0[0] + h0[1] * h0[1]) + (h0[2] * h0[2] + h0[3] * h0[3]) + (h1[0] * h1[0] + h1[1] * h1[1]) + (h1[2] * h1[2] + h1[3] * h1[3]);
                    if (HG) { const f32x4 g0 = *(const f32x4*)(gx + col), g1 = *(const f32x4*)(gx + col + 4);
                        u32x4 w; w.x = cvt_pk_bf16(h0[0] * g0[0], h0[1] * g0[1]); w.y = cvt_pk_bf16(h0[2] * g0[2], h0[3] * g0[3]); w.z = cvt_pk_bf16(h1[0] * g1[0], h1[1] * g1[1]); w.w = cvt_pk_bf16(h1[2] * g1[2], h1[3] * g1[3]);
                        *(u32x4*)(HG + row * ld + col) = w; } }
                ss += __shfl_xor(ss, 16); ss += __shfl_xor(ss, 32);
                if (fq == 0) atomicAdd(RS + row, ss); }
    }
};
struct EpiRowScale {
    static constexpr bool PERM = true, AFTER_DRAIN = false;
    bf16_t* O; int ldc; const float* RS; float sc;
    __device__ __forceinline__ void operator()(const f32x4 (&acc)[2][2][4][2], const Unit& u, int wr, int wc, int fr, int fq) const {
        const int row0 = u.pm * BM + wr * 64 + fr, col0 = u.pn * BM + wc * 32 + 8 * fq;
#pragma unroll
        for (int ai = 0; ai < 2; ++ai)
#pragma unroll
            for (int m = 0; m < 4; ++m) { const size_t row = (size_t)(row0 + ai * HALF + m * 16); const float rs = rsqrtf(RS[row] * (1.f / 4096.f) + 1e-6f) * sc;
#pragma unroll
                for (int bj = 0; bj < 2; ++bj) { const f32x4 v0 = acc[ai][bj][m][0] * rs, v1 = acc[ai][bj][m][1] * rs;
                    u32x4 w; w.x = cvt_pk_bf16(v0[0], v0[1]); w.y = cvt_pk_bf16(v0[2], v0[3]); w.z = cvt_pk_bf16(v1[0], v1[1]); w.w = cvt_pk_bf16(v1[2], v1[3]);
                    *(u32x4*)(O + row * ldc + col0 + bj * HALF) = w; } }
    }
};

template <bool ATOMIC> struct EpiF32 {
    static constexpr bool PERM = true, AFTER_DRAIN = false;
    float* O; int ldc;
    __device__ __forceinline__ void operator()(const f32x4 (&acc)[2][2][4][2], const Unit& u, int wr, int wc, int fr, int fq) const {
        const int row0 = u.pm * BM + wr * 64 + fr, col0 = u.pn * BM + wc * 32 + 8 * fq;
#pragma unroll
        for (int ai = 0; ai < 2; ++ai)
#pragma unroll
            for (int m = 0; m < 4; ++m) { float* rowp = O + (size_t)(row0 + ai * HALF + m * 16) * ldc + col0;
#pragma unroll
                for (int bj = 0; bj < 2; ++bj) {
                    if (ATOMIC) {
#pragma unroll
                        for (int e = 0; e < 4; ++e) { atomicAdd(rowp + bj * HALF + e, acc[ai][bj][m][0][e]); atomicAdd(rowp + bj * HALF + 4 + e, acc[ai][bj][m][1][e]); }
                    } else { *(f32x4*)(rowp + bj * HALF) = acc[ai][bj][m][0]; *(f32x4*)(rowp + bj * HALF + 4) = acc[ai][bj][m][1]; } } }
    }
};
template <class Epi, class Sched, bool ALIGN_EPI = false, bool SP2 = false>
__device__ __forceinline__ void gemm_phase(PG8_LAS unsigned char* lds, const Gemm g, const Sched& S, const Epi& E) {
    const int tid = threadIdx.x, wid = __builtin_amdgcn_readfirstlane(tid >> 6), lane = tid & 63, wr = wid >> 2, wc = wid & 3, fr = lane & 15, fq = lane >> 4;
    const int K = g.K, nt = K / BK, LD = g.ld ? g.ld : g.K;
    unsigned voffA[2], voffB[2];
#pragma unroll
    for (int i = 0; i < 2; ++i) { int R, C; stage_rc(tid * 16 + i * 8192, R, C); const int Rb = Epi::PERM ? ((R & ~31) + perm32(R & 31)) : R;
        voffA[i] = (unsigned)(R * LD + C) * 2u; voffB[i] = (unsigned)(Rb * LD + C) * 2u; }
    const size_t kstep = (size_t)(BK * 2);
    const size_t hstep = (size_t)HALF * LD * 2;
    const size_t tstep = 2 * hstep;
    const unsigned ldsw = (unsigned)wid * 1024u;
    const int aoff = lds_byte(wr * 64 + fr, fq * 8), boff = lds_byte(wc * 32 + fr, fq * 8);
#define PG8_SA(b, h) (((b) * 2 + (h)) * HTB)
#define PG8_SB(b, h) ((4 + (b) * 2 + (h)) * HTB)
#define PG8_STAGE(bufoff, gbase, voff) do { _Pragma("unroll") for (int _i = 0; _i < 2; ++_i) \
        __builtin_amdgcn_global_load_lds((const unsigned*)((const char*)(gbase) + (voff)[_i]), (PG8_LAS unsigned*)(lds + (bufoff) + ldsw + _i * 8192), 16, 0, 0); } while (0)
#define PG8_LDA(dst, b, h) do { _Pragma("unroll") for (int m = 0; m < 4; ++m) _Pragma("unroll") for (int k = 0; k < 2; ++k) dst[m][k] = *(const PG8_LAS bf16x8*)(lds + PG8_SA(b, h) + aoff + m * 2048 + k * 1024); } while (0)
#define PG8_LDB(dst, b, h) do { _Pragma("unroll") for (int n = 0; n < 2; ++n) _Pragma("unroll") for (int k = 0; k < 2; ++k) dst[n][k] = *(const PG8_LAS bf16x8*)(lds + PG8_SB(b, h) + boff + n * 2048 + k * 1024); } while (0)
#define PG8_MMA(ai, bj, At, Bt) do { __builtin_amdgcn_s_setprio(1); _Pragma("unroll") for (int m = 0; m < 4; ++m) _Pragma("unroll") for (int n = 0; n < 2; ++n) _Pragma("unroll") for (int k = 0; k < 2; ++k) \
        acc[ai][bj][m][n] = __builtin_amdgcn_mfma_f32_16x16x32_bf16(Bt[n][k], At[m][k], acc[ai][bj][m][n], 0, 0, 0); __builtin_amdgcn_s_setprio(0); } while (0)
#define PG8_WAIT_V(n) asm volatile("s_waitcnt vmcnt(" #n ")" ::: "memory")
#define PG8_WAIT_L(n) asm volatile("s_waitcnt lgkmcnt(" #n ")" ::: "memory")
#define PG8_BAR __builtin_amdgcn_s_barrier()
#define PG8_SCHED __builtin_amdgcn_sched_barrier(0)
    Unit cur, nxt; int ui = 0;
    if (!S.next(0, cur)) return;
    f32x4 acc[2][2][4][2];
#pragma unroll
    for (int a = 0; a < 2; ++a)
#pragma unroll
        for (int b = 0; b < 2; ++b)
#pragma unroll
            for (int m = 0; m < 4; ++m)
#pragma unroll
                for (int n = 0; n < 2; ++n) acc[a][b][m][n] = (f32x4){0.f, 0.f, 0.f, 0.f};
    bf16x8 At[4][2], B0[2][2], B1[2][2];
    const char* cA = (const char*)g.A + (size_t)cur.pm * tstep; const char* cB = (const char*)g.Bt + (size_t)cur.pn * tstep;
    S.a_ready(cur);
    if constexpr (SP2) {
        PG8_STAGE(PG8_SB(0, 0), cB, voffB); PG8_STAGE(PG8_SB(0, 1), cB + hstep, voffB); PG8_STAGE(PG8_SA(0, 0), cA, voffA); PG8_STAGE(PG8_SA(0, 1), cA + hstep, voffA);
        if (wr == 1) PG8_BAR;
        PG8_WAIT_V(2); PG8_BAR;
        PG8_STAGE(PG8_SB(1, 0), cB + kstep, voffB); PG8_STAGE(PG8_SA(1, 0), cA + kstep, voffA); PG8_STAGE(PG8_SB(1, 1), cB + hstep + kstep, voffB);
        PG8_WAIT_V(6); PG8_BAR;
    } else {
        PG8_STAGE(PG8_SB(0, 0), cB, voffB); PG8_STAGE(PG8_SA(0, 0), cA, voffA); PG8_STAGE(PG8_SB(0, 1), cB + hstep, voffB); PG8_STAGE(PG8_SA(0, 1), cA + hstep, voffA);
        if (wr == 1) PG8_BAR;
        PG8_WAIT_V(4); PG8_BAR;
        PG8_STAGE(PG8_SB(1, 0), cB + kstep, voffB); PG8_STAGE(PG8_SA(1, 0), cA + kstep, voffA); PG8_STAGE(PG8_SB(1, 1), cB + hstep + kstep, voffB);
        PG8_WAIT_V(6); PG8_BAR;
    }
    for (;;) {
        const bool has_next = S.next(ui + 1, nxt);
        const char* nA = has_next ? (const char*)g.A + (size_t)nxt.pm * tstep : cA; const char* nB = has_next ? (const char*)g.Bt + (size_t)nxt.pn * tstep : cB;
        for (int t = 0; t < nt; t += 2) {
            const bool last = (t == nt - 2);
            const char* a1 = cA + (size_t)(t + 1) * kstep;
            const char* a2 = last ? nA : cA + (size_t)(t + 2) * kstep; const char* b2 = last ? nB : cB + (size_t)(t + 2) * kstep;
            const char* a3 = a2 + kstep; const char* b3 = b2 + kstep;
            if (last && has_next) S.a_ready(nxt);
            if constexpr (SP2) {
            PG8_LDB(B0, 0, 0); PG8_LDB(B1, 0, 1); PG8_SCHED; PG8_LDA(At, 0, 0); PG8_STAGE(PG8_SA(1, 1), a1 + hstep, voffA);
            PG8_WAIT_V(8); PG8_WAIT_L(0); PG8_BAR; PG8_MMA(0, 0, At, B0); PG8_MMA(0, 1, At, B1); PG8_BAR; PG8_SCHED;
            PG8_LDA(At, 0, 1); PG8_STAGE(PG8_SB(0, 0), b2, voffB); PG8_STAGE(PG8_SB(0, 1), b2 + hstep, voffB); PG8_STAGE(PG8_SA(0, 0), a2, voffA);
            PG8_WAIT_V(8); PG8_WAIT_L(0); PG8_BAR; PG8_MMA(1, 0, At, B0); PG8_MMA(1, 1, At, B1); PG8_BAR; PG8_SCHED;
            PG8_LDB(B0, 1, 0); PG8_LDB(B1, 1, 1); PG8_SCHED; PG8_LDA(At, 1, 0); PG8_STAGE(PG8_SA(0, 1), a2 + hstep, voffA);
            PG8_WAIT_V(8); PG8_WAIT_L(0); PG8_BAR; PG8_MMA(0, 0, At, B0); PG8_MMA(0, 1, At, B1); PG8_BAR; PG8_SCHED;
            PG8_LDA(At, 1, 1); PG8_STAGE(PG8_SB(1, 0), b3, voffB); PG8_STAGE(PG8_SB(1, 1), b3 + hstep, voffB); PG8_STAGE(PG8_SA(1, 0), a3, voffA);
            PG8_WAIT_V(8); PG8_WAIT_L(0); PG8_BAR; PG8_MMA(1, 0, At, B0); PG8_MMA(1, 1, At, B1); PG8_BAR; PG8_SCHED;
            } else {
            PG8_LDB(B0, 0, 0); PG8_SCHED; PG8_LDA(At, 0, 0); PG8_STAGE(PG8_SA(1, 1), a1 + hstep, voffA);
            PG8_WAIT_L(8); PG8_BAR; PG8_WAIT_L(0); PG8_MMA(0, 0, At, B0); PG8_BAR; PG8_SCHED;
            PG8_LDB(B1, 0, 1); PG8_STAGE(PG8_SB(0, 0), b2, voffB);
            PG8_BAR; PG8_WAIT_L(0); PG8_MMA(0, 1, At, B1); PG8_BAR;
            PG8_LDA(At, 0, 1); PG8_STAGE(PG8_SA(0, 0), a2, voffA);
            PG8_BAR; PG8_WAIT_L(0); PG8_MMA(1, 0, At, B0); PG8_BAR; PG8_SCHED;
            PG8_STAGE(PG8_SB(0, 1), b2 + hstep, voffB);
            PG8_WAIT_V(6); PG8_BAR; PG8_MMA(1, 1, At, B1); PG8_BAR;
            PG8_LDB(B0, 1, 0); PG8_SCHED; PG8_LDA(At, 1, 0); PG8_STAGE(PG8_SA(0, 1), a2 + hstep, voffA);
            PG8_WAIT_L(8); PG8_BAR; PG8_WAIT_L(0); PG8_MMA(0, 0, At, B0); PG8_BAR; PG8_SCHED;
            PG8_LDB(B1, 1, 1); PG8_STAGE(PG8_SB(1, 0), b3, voffB);
            PG8_BAR; PG8_WAIT_L(0); PG8_MMA(0, 1, At, B1); PG8_BAR;
            PG8_LDA(At, 1, 1); PG8_STAGE(PG8_SA(1, 0), a3, voffA);
            PG8_BAR; PG8_WAIT_L(0); PG8_MMA(1, 0, At, B0); PG8_BAR; PG8_SCHED;
            PG8_STAGE(PG8_SB(1, 1), b3 + hstep, voffB);
            PG8_WAIT_V(6); PG8_BAR; PG8_MMA(1, 1, At, B1); PG8_BAR;
            }
        }
        if constexpr (ALIGN_EPI) { if (wr == 0) PG8_BAR; }
        if constexpr (!Epi::AFTER_DRAIN) { E(acc, cur, wr, wc, fr, fq); S.done(cur); }
        if (!has_next) break;
#pragma unroll
        for (int a = 0; a < 2; ++a)
#pragma unroll
            for (int b = 0; b < 2; ++b)
#pragma unroll
                for (int m = 0; m < 4; ++m)
#pragma unroll
                    for (int n = 0; n < 2; ++n) acc[a][b][m][n] = (f32x4){0.f, 0.f, 0.f, 0.f};
        cur = nxt; cA = nA; cB = nB; ++ui;
        if constexpr (ALIGN_EPI) { if (wr == 1) PG8_BAR; }
    }
    PG8_WAIT_V(0);
    if constexpr (!ALIGN_EPI) { if (wr == 0) PG8_BAR; }
    PG8_BAR;
    if constexpr (Epi::AFTER_DRAIN) { E.fused(acc, cur, wr, wc, fr, fq, lds, wid, lane); S.done(cur); }
#undef PG8_SA
#undef PG8_SB
#undef PG8_STAGE
#undef PG8_LDA
#undef PG8_LDB
#undef PG8_MMA
#undef PG8_WAIT_V
#undef PG8_WAIT_L
#undef PG8_BAR
#undef PG8_SCHED
}
}

#define LAS __attribute__((address_space(3)))
typedef pg8::bf16_t bf16_t;
typedef pg8::bf16x8 bf16x8;
typedef pg8::f32x4 f32x4;
typedef pg8::u32x4 u32x4;
typedef float f32x16 __attribute__((ext_vector_type(16)));
typedef short s16x4 __attribute__((ext_vector_type(4)));
typedef int i32x4 __attribute__((ext_vector_type(4)));

constexpr int SEQ = 8192, DM = 4096, INW = 36864, MEML = 256;
constexpr int C_Q = 0, C_K = 4096, C_V = 8192, C_ZA = 12288, C_UB = 16384, C_VB = 20480, C_ZB = 24576, C_G = 28672;
constexpr float LOG2E = 1.4426950408889634f;
constexpr float QSCALE = 0.08838834764831845f * LOG2E;
constexpr float EPS = 1e-6f;

constexpr size_t MiB = 1u << 20;
constexpr size_t WS_RS = 0, WS_RS2 = 32768, WS_TMETA = 65536, WS_BAR = 131072, BAR_BYTES = 16384;
constexpr size_t WS_WIN = 1 * MiB;
constexpr size_t WS_WPA = WS_WIN + 288 * MiB, WS_WPB = WS_WPA + 32 * MiB, WS_WOUT = WS_WPB + 32 * MiB;
constexpr size_t WS_WXQ = WS_WOUT + 32 * MiB, WS_WXKV = WS_WXQ + 4 * MiB, WS_WXO = WS_WXKV + 8 * MiB;
constexpr size_t WS_HN = WS_WXO + 4 * MiB;
constexpr size_t WS_MN = WS_HN + 64 * MiB;
constexpr size_t WS_PROJ = WS_MN + 2 * MiB;
constexpr size_t WS_AA = WS_PROJ + 576 * MiB, WS_AB = WS_AA + 64 * MiB;
constexpr size_t WS_TMP = WS_AB + 64 * MiB;
constexpr size_t WS_MRG = WS_TMP + 128 * MiB;
constexpr size_t WS_H1 = WS_MRG + 64 * MiB;
constexpr size_t WS_HG = WS_H1 + 128 * MiB;
constexpr size_t WS_QX = WS_HG + 64 * MiB;
constexpr size_t WS_KVX = WS_QX + 8 * MiB;
constexpr size_t WS_OX = WS_KVX + 1 * MiB;
constexpr size_t WS_KVF = WS_OX + 8 * MiB;
constexpr size_t WS_END = WS_KVF + 16 * MiB;

constexpr int STAGE = 65536;
constexpr int LUT_OFF = 131072, WSF_OFF = 131072 + 1024, SS_OFF = 131072 + 2048, TM_OFF = 131072 + 3072, POSK_OFF = 131072 + 4096, XM_OFF = 131072 + 4608, PB_OFF = 131072 + 4608 + 4096, XBST_OFF = 131072 + 4608 + 4096 + 16384, LDS_BYTES = 131072 + 4608 + 4096 + 16384 + 16;

struct Args {
    const float *x; const int* pos; const float *mem, *w_in, *b_gate, *norm1_g, *lq1, *lk1, *lq2, *lk2, *subln_g, *rel_bias, *sg_ln_g, *sg_ln_b, *sg_w, *sg_b,
                *w_pa, *w_pb, *w_out, *norm_x_g, *norm_mem_g, *w_xq, *w_xkv, *w_xo, *final_g;
    float* out; unsigned char* ws; int lo, hi;
};

__device__ __forceinline__ float wave_sum(float v) {
#pragma unroll
    for (int o = 1; o < 64; o <<= 1) v += __shfl_xor(v, o);
    return v;
}
__device__ __forceinline__ unsigned pk2(float lo, float hi) { return pg8::cvt_pk_bf16(lo, hi); }
__device__ __forceinline__ float bf2f(unsigned b) { return __uint_as_float(b << 16); }
__device__ __forceinline__ void glds16(const void* g, LAS unsigned char* l) { unsigned keep; const unsigned dst = (unsigned)__builtin_amdgcn_readfirstlane((int)(unsigned)(uintptr_t)l);
    asm volatile("s_mov_b32 %0, m0\n\ts_mov_b32 m0, %2\n\ts_nop 0\n\tglobal_load_lds_dwordx4 %1, off\n\ts_mov_b32 m0, %0" : "=&s"(keep) : "v"(g), "s"(dst) : "memory"); }
__device__ __forceinline__ s16x4 trr(const LAS unsigned char* p) { return __builtin_bit_cast(s16x4, __builtin_amdgcn_ds_read_tr16_b64_v4i16((LAS s16x4*)p)); }
__device__ __forceinline__ int crow(int r, int hi) { return (r & 3) + 8 * (r >> 2) + 4 * hi; }

__device__ __forceinline__ void p0_transpose_item(const float* W, int K, int N, bf16_t* WT, LAS float* scr, int item, int lane) {
    const int nblk = N / 32, kb = item / nblk, nb = item % nblk, k0 = 64 * kb, n0 = 32 * nb;
    float wv[32];
#pragma unroll
    for (int i = 0; i < 32; ++i) wv[i] = W[(size_t)(k0 + 2 * i + (lane >> 5)) * N + n0 + (lane & 31)];
#pragma unroll
    for (int i = 0; i < 32; ++i) scr[(2 * i + (lane >> 5)) * 33 + (lane & 31)] = wv[i];
    __builtin_amdgcn_fence(__ATOMIC_RELEASE, "wavefront"); asm volatile("s_waitcnt lgkmcnt(0)" ::: "memory");
    const int c = lane & 7;
#pragma unroll
    for (int j = 0; j < 4; ++j) { const int n = (lane >> 3) + 8 * j; const LAS float* s = scr + (8 * c) * 33 + n;
        u32x4 o; o.x = pk2(s[0 * 33], s[1 * 33]); o.y = pk2(s[2 * 33], s[3 * 33]); o.z = pk2(s[4 * 33], s[5 * 33]); o.w = pk2(s[6 * 33], s[7 * 33]);
        *(u32x4*)(WT + (size_t)(n0 + n) * K + k0 + 8 * c) = o; }
    asm volatile("s_waitcnt lgkmcnt(0)" ::: "memory");
}
__device__ __forceinline__ void rms_row_to_bf16(const float* xrow, const float* g, bf16_t* orow, int lane) {
    const f32x4* xr = (const f32x4*)xrow + lane; const f32x4* gr = (const f32x4*)g + lane;
    f32x4 v[16]; float s = 0.f;
#pragma unroll
    for (int j = 0; j < 16; ++j) { v[j] = xr[64 * j]; s += (v[j].x * v[j].x + v[j].y * v[j].y) + (v[j].z * v[j].z + v[j].w * v[j].w); }
    const float rstd = rsqrtf(wave_sum(s) * (1.f / 4096.f) + EPS);
    unsigned long long* o8 = (unsigned long long*)orow + lane;
#pragma unroll
    for (int j = 0; j < 16; ++j) { const f32x4 gg = gr[64 * j];
        o8[64 * j] = (unsigned long long)pk2(v[j].x * rstd * gg.x, v[j].y * rstd * gg.y) | ((unsigned long long)pk2(v[j].z * rstd * gg.z, v[j].w * rstd * gg.w) << 32); }
}

__device__ __forceinline__ void glds4(const void* g, LAS unsigned char* l) { unsigned keep; const unsigned dst = (unsigned)__builtin_amdgcn_readfirstlane((int)(unsigned)(uintptr_t)l);
    asm volatile("s_mov_b32 %0, m0\n\ts_mov_b32 m0, %2\n\ts_nop 0\n\tglobal_load_lds_dword %1, off\n\ts_mov_b32 m0, %0" : "=&s"(keep) : "v"(g), "s"(dst) : "memory"); }
template <int NVB>
__device__ __forceinline__ void attn_dma(LAS unsigned char* st, int wid, int lane, const bf16_t* K0, const bf16_t* K1, size_t kpitch, const bf16_t* V, size_t vpitch) {
#pragma unroll
    for (int i2 = 0; i2 < 2; ++i2) { const int i = wid * 2 + i2, row = 4 * i + (lane >> 4), pc = lane & 15, lc = pc ^ (row & 15);
        glds16(K0 + (size_t)row * kpitch + lc * 8, st + i * 1024);
        glds16(K1 + (size_t)row * kpitch + lc * 8, st + 16384 + i * 1024); }
    if (NVB == 8) {
#pragma unroll
        for (int i4 = 0; i4 < 4; ++i4) { const int i = wid * 4 + i4, row = 2 * i + (lane >> 5), pc = lane & 31, lc = pc ^ ((row & 7) << 2);
            glds16(V + (size_t)row * vpitch + lc * 8, st + 32768 + i * 1024); }
    } else {
#pragma unroll
        for (int i2 = 0; i2 < 2; ++i2) { const int i = wid * 2 + i2, row = 4 * i + (lane >> 4), pc = lane & 15, lc = pc ^ ((row & 3) << 2);
            glds16(V + (size_t)row * vpitch + lc * 8, st + 32768 + i * 1024); }
    }
}

template <int NO, int NVB, bool MASKED>
__device__ __forceinline__ void attn_tile(bool NEAR, const LAS unsigned char* Kst, const LAS unsigned char* Vst, const bf16x8 (&qf)[8], f32x16 (&O)[NO], float& m_ref, float& l_part,
                                          LAS float* wsf, int lane, const LAS int* posk, int qpos, const LAS float* lut, int cbase) {
    const int r32 = lane & 31, h = lane >> 5;
    const LAS unsigned char* kb_ = Kst + r32 * 256;
    const int sw = r32 & 15;
    constexpr int ROWB = NVB * 64;
    const int blk = (lane >> 4) & 1, q = (lane & 15) >> 2, p = lane & 3;
    const int swl = (NVB == 8) ? (4 * h + q) : q;
    const LAS unsigned char* vb = Vst + (4 * h + q) * ROWB + blk * 32 + p * 8;
    const float nm = -m_ref;
    f32x16 S0 = {nm, nm, nm, nm, nm, nm, nm, nm, nm, nm, nm, nm, nm, nm, nm, nm}, S1 = S0;
#pragma unroll
    for (int dg = 0; dg < 2; ++dg) {
        bf16x8 kf0[4], kf1[4];
#pragma unroll
        for (int d = 0; d < 4; ++d) { const int co = ((2 * (4 * dg + d) + h) ^ sw) << 4; kf0[d] = *(const LAS bf16x8*)(kb_ + co); kf1[d] = *(const LAS bf16x8*)(kb_ + 8192 + co); }
        __builtin_amdgcn_sched_barrier(0);
#pragma unroll
        for (int d = 0; d < 4; ++d) {
            S0 = __builtin_amdgcn_mfma_f32_32x32x16_bf16(kf0[d], qf[4 * dg + d], S0, 0, 0, 0);
            S1 = __builtin_amdgcn_mfma_f32_32x32x16_bf16(kf1[d], qf[4 * dg + d], S1, 0, 0, 0);
        }
        __builtin_amdgcn_sched_barrier(0);
    }
    if (MASKED && NEAR) {
        float b0[16], b1[16];
#pragma unroll
        for (int g4 = 0; g4 < 4; ++g4) { const i32x4 pk0 = *(const LAS i32x4*)(posk + 8 * g4 + 4 * h), pk1 = *(const LAS i32x4*)(posk + 32 + 8 * g4 + 4 * h);
#pragma unroll
            for (int i = 0; i < 4; ++i) { const int rel0 = qpos - pk0[i], rel1 = qpos - pk1[i];
                b0[4 * g4 + i] = lut[rel0 < 0 ? 129 : (rel0 > 128 ? 128 : rel0)]; b1[4 * g4 + i] = lut[rel1 < 0 ? 129 : (rel1 > 128 ? 128 : rel1)]; } }
#pragma unroll
        for (int r = 0; r < 16; ++r) { S0[r] += b0[r]; S1[r] += b1[r]; }
    }
    float mt = fmaxf(S0[0], S1[0]);
#pragma unroll
    for (int r = 1; r < 16; ++r) mt = fmaxf(mt, fmaxf(S0[r], S1[r]));
    mt = fmaxf(mt, __shfl_xor(mt, 32));
    const bool need = mt > 8.f;
    if (__any(need)) {
        const float dl = need ? mt : 0.f;
        const float alpha = pg8::ex2_(-dl);
        l_part *= alpha; m_ref += dl;
#pragma unroll
        for (int r = 0; r < 16; ++r) { S0[r] -= dl; S1[r] -= dl; }
        wsf[r32] = alpha;
#pragma unroll
        for (int g4 = 0; g4 < 4; ++g4) { const f32x4 a = *(const LAS f32x4*)(wsf + 8 * g4 + 4 * h);
#pragma unroll
            for (int c = 0; c < NO; ++c)
#pragma unroll
                for (int i = 0; i < 4; ++i) O[c][4 * g4 + i] *= a[i]; }
    }
    float ls = 0.f;
#pragma unroll
    for (int r = 0; r < 16; ++r) { const float p0 = pg8::ex2_(S0[r]), p1 = pg8::ex2_(S1[r]); S0[r] = p0; S1[r] = p1; ls += p0 + p1; }
    l_part += ls;
    bf16x8 pa[2][2];
#pragma unroll
    for (int ks = 0; ks < 2; ++ks) {
        u32x4 w; w.x = pk2(S0[8 * ks + 0], S0[8 * ks + 1]); w.y = pk2(S0[8 * ks + 2], S0[8 * ks + 3]); w.z = pk2(S0[8 * ks + 4], S0[8 * ks + 5]); w.w = pk2(S0[8 * ks + 6], S0[8 * ks + 7]); pa[0][ks] = __builtin_bit_cast(bf16x8, w);
        u32x4 x; x.x = pk2(S1[8 * ks + 0], S1[8 * ks + 1]); x.y = pk2(S1[8 * ks + 2], S1[8 * ks + 3]); x.z = pk2(S1[8 * ks + 4], S1[8 * ks + 5]); x.w = pk2(S1[8 * ks + 6], S1[8 * ks + 7]); pa[1][ks] = __builtin_bit_cast(bf16x8, x); }
    __builtin_amdgcn_sched_barrier(0);
    {
        bf16x8 vf[2][NO];
#define LOADV(buf, g) do { _Pragma("unroll") for (int c = 0; c < NO; ++c) { const LAS unsigned char* a0 = vb + (16 * (g)) * ROWB + (((c + cbase) ^ swl) << 6); \
            const s16x4 lo = trr(a0), hi = trr(a0 + 8 * ROWB); vf[buf][c] = (bf16x8){lo[0], lo[1], lo[2], lo[3], hi[0], hi[1], hi[2], hi[3]}; } } while (0)
        LOADV(0, 0);
#pragma unroll
        for (int g = 0; g < 4; ++g) {
            if (g + 1 < 4) LOADV((g + 1) & 1, g + 1);
            __builtin_amdgcn_sched_barrier(0);
#pragma unroll
            for (int c = 0; c < NO; ++c) O[c] = __builtin_amdgcn_mfma_f32_32x32x16_bf16(pa[g >> 1][g & 1], vf[g & 1][c], O[c], 0, 0, 0);
            __builtin_amdgcn_sched_barrier(0);
        }
#undef LOADV
    }
}

__device__ __forceinline__ void attn_tile_pair(bool NEAR, bool first, int par, const LAS unsigned char* Kst, const LAS unsigned char* Vst, const bf16x8 (&qf)[8], f32x16 (&O)[4], float& m_ref, float& l_part,
                                               LAS float* wsf, LAS float* xm, LAS unsigned char* pb, int wid, int lane, const LAS int* posk, int qpos, const LAS float* lut, int dh) {
    const int r32 = lane & 31, h = lane >> 5;
    if (!first) {
        const float mt = fmaxf(xm[((par ^ 1) * 8 + wid) * 64 + r32], xm[((par ^ 1) * 8 + (wid ^ 2)) * 64 + r32]);
        const bool need = mt > 8.f;
        if (__any(need)) {
            const float dl = need ? mt : 0.f; const float alpha = pg8::ex2_(-dl);
            l_part *= alpha; m_ref += dl;
            wsf[r32] = alpha;
#pragma unroll
            for (int g4 = 0; g4 < 4; ++g4) { const f32x4 a = *(const LAS f32x4*)(wsf + 8 * g4 + 4 * h);
#pragma unroll
                for (int c = 0; c < 4; ++c)
#pragma unroll
                    for (int i = 0; i < 4; ++i) O[c][4 * g4 + i] *= a[i]; }
        }
    }
    const LAS unsigned char* kb_ = Kst + (32 * dh + r32) * 256;
    const int sw = r32 & 15;
    const float nm = -m_ref;
    f32x16 S = {nm, nm, nm, nm, nm, nm, nm, nm, nm, nm, nm, nm, nm, nm, nm, nm}, T = {0.f, 0.f, 0.f, 0.f, 0.f, 0.f, 0.f, 0.f, 0.f, 0.f, 0.f, 0.f, 0.f, 0.f, 0.f, 0.f};
    {
        bf16x8 kf[8];
#pragma unroll
        for (int d0 = 0; d0 < 8; ++d0) kf[d0] = *(const LAS bf16x8*)(kb_ + (((2 * d0 + h) ^ sw) << 4));
        __builtin_amdgcn_sched_barrier(0);
#pragma unroll
        for (int d = 0; d < 4; ++d) {
            S = __builtin_amdgcn_mfma_f32_32x32x16_bf16(kf[d], qf[d], S, 0, 0, 0);
            T = __builtin_amdgcn_mfma_f32_32x32x16_bf16(kf[4 + d], qf[4 + d], T, 0, 0, 0);
        }
    }
    __builtin_amdgcn_sched_barrier(0);
#pragma unroll
    for (int r = 0; r < 16; ++r) S[r] += T[r];
    if (NEAR) {
        float b0[16];
#pragma unroll
        for (int g4 = 0; g4 < 4; ++g4) { const i32x4 pk0 = *(const LAS i32x4*)(posk + 32 * dh + 8 * g4 + 4 * h);
#pragma unroll
            for (int i = 0; i < 4; ++i) { const int rel0 = qpos - pk0[i]; b0[4 * g4 + i] = lut[rel0 < 0 ? 129 : (rel0 > 128 ? 128 : rel0)]; } }
#pragma unroll
        for (int r = 0; r < 16; ++r) S[r] += b0[r];
    }
    float mt = S[0];
#pragma unroll
    for (int r = 1; r < 16; ++r) mt = fmaxf(mt, S[r]);
    mt = fmaxf(mt, __shfl_xor(mt, 32));
    xm[(par * 8 + wid) * 64 + r32] = mt;
    float ls = 0.f;
#pragma unroll
    for (int r = 0; r < 16; ++r) { const float p0 = pg8::ex2_(S[r]); S[r] = p0; ls += p0; }
    l_part += ls;
    u32x4 mine[2];
#pragma unroll
    for (int ks = 0; ks < 2; ++ks) { mine[ks].x = pk2(S[8 * ks + 0], S[8 * ks + 1]); mine[ks].y = pk2(S[8 * ks + 2], S[8 * ks + 3]); mine[ks].z = pk2(S[8 * ks + 4], S[8 * ks + 5]); mine[ks].w = pk2(S[8 * ks + 6], S[8 * ks + 7]);
        *(LAS u32x4*)(pb + ((wid * 2 + ks) * 64 + lane) * 16) = mine[ks]; }
    const int blk = (lane >> 4) & 1, q = (lane & 15) >> 2, p = lane & 3;
    const int swl = 4 * h + q, cbase = 4 * dh;
    const LAS unsigned char* vb = Vst + (4 * h + q) * 512 + blk * 32 + p * 8;
    bf16x8 vf[2][4];
#define LOADV(buf, g) do { _Pragma("unroll") for (int c = 0; c < 4; ++c) { const LAS unsigned char* a0 = vb + (16 * (g)) * 512 + (((c + cbase) ^ swl) << 6); \
        const s16x4 lo = trr(a0), hi = trr(a0 + 8 * 512); vf[buf][c] = (bf16x8){lo[0], lo[1], lo[2], lo[3], hi[0], hi[1], hi[2], hi[3]}; } } while (0)
    LOADV(0, 0);
    __syncthreads();
    u32x4 oth[2];
#pragma unroll
    for (int ks = 0; ks < 2; ++ks) oth[ks] = *(const LAS u32x4*)(pb + (((wid ^ 2) * 2 + ks) * 64 + lane) * 16);
    bf16x8 pa[2][2];
#pragma unroll
    for (int ks = 0; ks < 2; ++ks) { const u32x4 lo = dh ? oth[ks] : mine[ks], hi = dh ? mine[ks] : oth[ks]; pa[0][ks] = __builtin_bit_cast(bf16x8, lo); pa[1][ks] = __builtin_bit_cast(bf16x8, hi); }
    {
#pragma unroll
        for (int g = 0; g < 4; ++g) {
            if (g + 1 < 4) LOADV((g + 1) & 1, g + 1);
            __builtin_amdgcn_sched_barrier(0);
#pragma unroll
            for (int c = 0; c < 4; ++c) O[c] = __builtin_amdgcn_mfma_f32_32x32x16_bf16(pa[g >> 1][g & 1], vf[g & 1][c], O[c], 0, 0, 0);
            __builtin_amdgcn_sched_barrier(0);
        }
#undef LOADV
    }
}

template <int NVB>
__device__ __forceinline__ void scale_rows(f32x16 (&O)[NVB], float val, LAS float* wsf, int lane) {
    const int r32 = lane & 31, h = lane >> 5;
    wsf[r32] = val;
#pragma unroll
    for (int g4 = 0; g4 < 4; ++g4) { const f32x4 a = *(const LAS f32x4*)(wsf + 8 * g4 + 4 * h);
#pragma unroll
        for (int c = 0; c < NVB; ++c)
#pragma unroll
            for (int i = 0; i < 4; ++i) O[c][4 * g4 + i] *= a[i]; }
}

__device__ __forceinline__ int next_tile(const LAS int* tmin, int j, int qmax) { while (j < 128 && tmin[j] > qmax) ++j; return j; }

__device__ __forceinline__ void diff_attn_unit(LAS unsigned char* lds, const Args& A, int h, int qb, float lam, int tid, int wid, int lane) {
    asm volatile("" : "+v"(tid), "+v"(lane), "+s"(wid));
    const bf16_t* PROJ = (const bf16_t*)(A.ws + WS_PROJ); bf16_t* AA = (bf16_t*)(A.ws + WS_AA);
    const LAS int* tmin = (const LAS int*)(lds + TM_OFF); const LAS int* tmax = tmin + 128;
    const int grp = wid >> 2, wsub = wid & 3, rb = wsub & 1, dh = wsub >> 1, r32 = lane & 31, hh = lane >> 5;
    LAS float* lut = (LAS float*)(lds + LUT_OFF);
    LAS float* wsf = (LAS float*)(lds + WSF_OFF) + wid * 32;
    LAS float* SS = (LAS float*)(lds + SS_OFF);
    if (tid == 129) lut[129] = -INFINITY;
    if (tid < 129) { const int n = tid; float v = 0.f;
        if (n < 128) { int b; if (n < 16) b = n; else { const float lg = logf((float)n * (1.f / 16.f)) / 2.0794415416798357f * 16.f; b = 16 + (int)lg; b = b > 31 ? 31 : b; }
            v = (A.rel_bias[b * 16 + h] - A.rel_bias[31 * 16 + h]) * LOG2E; }
        lut[n] = v; }
    const int row0 = qb * 64, myrow = row0 + 32 * rb + r32;
    const bf16_t* Qp = PROJ + (size_t)myrow * INW + C_Q + h * 256 + grp * 128 + 8 * hh;
    bf16x8 qf[8];
#pragma unroll
    for (int d0 = 0; d0 < 8; ++d0) qf[d0] = *(const bf16x8*)(Qp + 16 * d0);
    const int qpos = A.pos[myrow];
    const bf16_t* Kb0 = PROJ + C_K + h * 256; const bf16_t* Kb1 = Kb0 + 128; const bf16_t* Vb = PROJ + C_V + h * 256;
    const int qmin = tmin[qb], qmax = tmax[qb];
    f32x16 O[4];
#pragma unroll
    for (int c = 0; c < 4; ++c)
#pragma unroll
        for (int r = 0; r < 16; ++r) O[c][r] = 0.f;
    float m_ref = 0.f, l_part = 0.f;
    int j = next_tile(tmin, 0, qmax), s = 0; bool first = true;
    __syncthreads();
    if (j < 128) attn_dma<8>(lds, wid, lane, Kb0 + (size_t)j * 64 * INW, Kb1 + (size_t)j * 64 * INW, INW, Vb + (size_t)j * 64 * INW, INW);
    if (j < 128 && wid == 0) glds4(A.pos + j * 64 + lane, lds + POSK_OFF);
    while (j < 128) {
        asm volatile("s_waitcnt vmcnt(0)" ::: "memory"); __syncthreads();
        const int jn = next_tile(tmin, j + 1, qmax);
        if (jn < 128) attn_dma<8>(lds + (s ^ 1) * STAGE, wid, lane, Kb0 + (size_t)jn * 64 * INW, Kb1 + (size_t)jn * 64 * INW, INW, Vb + (size_t)jn * 64 * INW, INW);
        if (jn < 128 && wid == 0) glds4(A.pos + jn * 64 + lane, lds + POSK_OFF + (s ^ 1) * 256);
        const bool near = (qmin - tmax[j]) < 128;
        const LAS unsigned char* st = lds + s * STAGE;
        attn_tile_pair(near, first, s, st + grp * 16384, st + 32768, qf, O, m_ref, l_part, wsf, (LAS float*)(lds + XM_OFF), lds + PB_OFF, wid, lane, (const LAS int*)(lds + POSK_OFF + s * 256), qpos, lut, dh);
        first = false; j = jn; s ^= 1;
    }
    float lt = l_part + __shfl_xor(l_part, 32);
    { LAS float* xl = (LAS float*)(lds + XM_OFF); __syncthreads(); xl[wid * 64 + r32] = lt; __syncthreads(); lt += xl[(wid ^ 2) * 64 + r32]; }
    scale_rows<4>(O, pg8::rcp_(lt) * (grp ? lam : 1.f), wsf, lane);
    __syncthreads();
    LAS float* X = (LAS float*)lds;
    if (grp == 1) {
#pragma unroll
        for (int c = 0; c < 4; ++c)
#pragma unroll
            for (int r = 0; r < 16; ++r) X[((wsub * 4 + c) * 16 + r) * 64 + lane] = O[c][r];
    }
    __syncthreads();
    float ss[16];
    if (grp == 0) {
#pragma unroll
        for (int r = 0; r < 16; ++r) ss[r] = 0.f;
#pragma unroll
        for (int c = 0; c < 4; ++c)
#pragma unroll
            for (int r = 0; r < 16; ++r) { const float o = O[c][r] - X[((wsub * 4 + c) * 16 + r) * 64 + lane]; O[c][r] = o; ss[r] += o * o; }
#pragma unroll
        for (int r = 0; r < 16; ++r) { float v = ss[r]; v += __shfl_xor(v, 1); v += __shfl_xor(v, 2); v += __shfl_xor(v, 4); v += __shfl_xor(v, 8); v += __shfl_xor(v, 16); ss[r] = v;
            if (r32 == 0) SS[(wsub * 2 + hh) * 16 + r] = v; }
    }
    __syncthreads();
    if (grp == 0) {
#pragma unroll
        for (int r = 0; r < 16; ++r) ss[r] = rsqrtf((ss[r] + SS[((wsub ^ 2) * 2 + hh) * 16 + r]) * (1.f / 256.f) + EPS) * 0.8f;
        const bf16_t* zb = PROJ + (size_t)(row0 + 32 * rb + 4 * hh) * INW + C_ZA + h * 256 + 128 * dh + r32;
        bf16_t* ob = AA + (size_t)(row0 + 32 * rb + 4 * hh) * DM + h * 256 + 128 * dh + r32;
#pragma unroll
        for (int c = 0; c < 4; ++c) { const float gs = A.subln_g[128 * dh + 32 * c + r32];
            unsigned zz[16];
#pragma unroll
            for (int r = 0; r < 16; ++r) { const int rr = (r & 3) + 8 * (r >> 2); zz[r] = zb[(size_t)rr * INW + 32 * c]; }
#pragma unroll
            for (int r = 0; r < 16; ++r) { const int rr = (r & 3) + 8 * (r >> 2);
                ob[(size_t)rr * DM + 32 * c] = (bf16_t)(pk2(O[c][r] * ss[r] * gs * bf2f(zz[r]), 0.f) & 0xffffu); }
            __builtin_amdgcn_sched_barrier(0);
        }
    }
    __syncthreads();
}

__device__ __forceinline__ void cross_attn_unit(LAS unsigned char* lds, const Args& A, int h, int qb, int tid, int wid, int lane) {
    asm volatile("" : "+v"(tid), "+v"(lane), "+s"(wid));
    const bf16_t* QX = (const bf16_t*)(A.ws + WS_QX); const bf16_t* KVX = (const bf16_t*)(A.ws + WS_KVX); bf16_t* OX = (bf16_t*)(A.ws + WS_OX);
    const int grp = wid >> 2, wsub = wid & 3, r32 = lane & 31, hh = lane >> 5;
    LAS float* wsf = (LAS float*)(lds + WSF_OFF) + wid * 32;
    const int row0 = qb * 256 + grp * 128 + 32 * wsub, myrow = row0 + r32;
    const float* Qp = (const float*)(A.ws + WS_TMP) + (size_t)myrow * 512 + h * 128 + 8 * hh;
    const float qrs = rsqrtf(((const float*)(A.ws + WS_RS))[myrow] * (1.f / 4096.f) + EPS) * QSCALE;
    bf16x8 qf[8];
#pragma unroll
    for (int d0 = 0; d0 < 8; ++d0) { f32x4 a0 = {0.f, 0.f, 0.f, 0.f}, a1 = a0;
#pragma unroll
        for (int ks = 0; ks < 4; ++ks) { a0 += *(const f32x4*)(Qp + (size_t)ks * SEQ * 512 + 16 * d0); a1 += *(const f32x4*)(Qp + (size_t)ks * SEQ * 512 + 16 * d0 + 4); }
        u32x4 w; w.x = pk2(a0[0] * qrs, a0[1] * qrs); w.y = pk2(a0[2] * qrs, a0[3] * qrs); w.z = pk2(a1[0] * qrs, a1[1] * qrs); w.w = pk2(a1[2] * qrs, a1[3] * qrs);
        qf[d0] = __builtin_bit_cast(bf16x8, w); }
    const bf16_t* Kb = KVX + h * 128; const bf16_t* Vb = KVX + 512 + h * 128;
    f32x16 O[4];
#pragma unroll
    for (int c = 0; c < 4; ++c)
#pragma unroll
        for (int r = 0; r < 16; ++r) O[c][r] = 0.f;
    float m_ref = 0.f, l_part = 0.f;
    __syncthreads();
    attn_dma<4>(lds, wid, lane, Kb, Kb, 1024, Vb, 1024);
    int s = 0;
    for (int j = 0; j < 4; ++j) {
        asm volatile("s_waitcnt vmcnt(0)" ::: "memory"); __syncthreads();
        if (j + 1 < 4) attn_dma<4>(lds + (s ^ 1) * STAGE, wid, lane, Kb + (size_t)(j + 1) * 64 * 1024, Kb + (size_t)(j + 1) * 64 * 1024, 1024, Vb + (size_t)(j + 1) * 64 * 1024, 1024);
        const LAS unsigned char* st = lds + s * STAGE;
        attn_tile<4, 4, false>(false, st + grp * 16384, st + 32768, qf, O, m_ref, l_part, wsf, lane, (const LAS int*)(lds + POSK_OFF), 0, (const LAS float*)(lds + LUT_OFF), 0);
        s ^= 1;
    }
    const float lt = l_part + __shfl_xor(l_part, 32);
    scale_rows<4>(O, pg8::rcp_(lt), wsf, lane);
#pragma unroll
    for (int c = 0; c < 4; ++c)
#pragma unroll
        for (int r = 0; r < 16; ++r) OX[(size_t)(row0 + crow(r, hh)) * 512 + h * 128 + 32 * c + r32] = (bf16_t)(pk2(O[c][r], 0.f) & 0xffffu);
    __syncthreads();
}

__device__ __forceinline__ void mixb_unit(LAS unsigned char* lds, const Args& A, int n, int gq, int tid, int wid, int lane) {
    asm volatile("" : "+v"(tid), "+v"(lane), "+s"(wid));
    const bf16_t* PROJ = (const bf16_t*)(A.ws + WS_PROJ); bf16_t* AB = (bf16_t*)(A.ws + WS_AB);
    LAS float* stats = (LAS float*)(lds + 98304);
    const int r32 = lane & 31, hh = lane >> 5;
    __syncthreads();
    for (int rr = 0; rr < 16; ++rr) {
        const int trow = 16 * wid + rr; const bf16_t* src = PROJ + (size_t)(128 * n + trow) * INW + C_VB;
        u32x4 v[8]; float s = 0.f;
#pragma unroll
        for (int j = 0; j < 8; ++j) { v[j] = *(const u32x4*)(src + (lane + 64 * j) * 8);
            s += (bf2f(v[j].x & 0xffffu) + bf2f(v[j].x >> 16)) + (bf2f(v[j].y & 0xffffu) + bf2f(v[j].y >> 16)) + (bf2f(v[j].z & 0xffffu) + bf2f(v[j].z >> 16)) + (bf2f(v[j].w & 0xffffu) + bf2f(v[j].w >> 16)); }
        const float mean = wave_sum(s) * (1.f / 4096.f); float q = 0.f;
#pragma unroll
        for (int j = 0; j < 8; ++j) {
#pragma unroll
            for (int e = 0; e < 4; ++e) { const unsigned w = v[j][e]; const float a = bf2f(w & 0xffffu) - mean, b = bf2f(w >> 16) - mean; q += a * a + b * b; } }
        const float rstd = rsqrtf(wave_sum(q) * (1.f / 4096.f) + EPS);
        if (lane == 0) { stats[2 * trow] = mean; stats[2 * trow + 1] = rstd; }
    }
    __syncthreads();
    for (int gi = 0; gi < 4; ++gi) {
        const int g = gq * 4 + gi;
#pragma unroll
        for (int i = 0; i < 4; ++i) { const int id = tid + 512 * i, t = id >> 4, lc = id & 15; const float* wp = A.sg_w + ((size_t)g * 128 + t) * 128 + lc * 8;
            f32x4 w0 = *(const f32x4*)wp, w1 = *(const f32x4*)(wp + 4);
#pragma unroll
            for (int e = 0; e < 4; ++e) { if (lc * 8 + e > t) w0[e] = 0.f; if (lc * 8 + 4 + e > t) w1[e] = 0.f; }
            u32x4 o; o.x = pk2(w0[0], w0[1]); o.y = pk2(w0[2], w0[3]); o.z = pk2(w1[0], w1[1]); o.w = pk2(w1[2], w1[3]);
            *(LAS u32x4*)(lds + t * 256 + ((lc ^ (t & 15)) << 4)) = o; }
        { const int lc = tid & 31, ch = g * 256 + lc * 8;
          const f32x4 g0 = *(const f32x4*)(A.sg_ln_g + ch), g1 = *(const f32x4*)(A.sg_ln_g + ch + 4), b0 = *(const f32x4*)(A.sg_ln_b + ch), b1 = *(const f32x4*)(A.sg_ln_b + ch + 4);
          u32x4 xr[8];
#pragma unroll
          for (int i = 0; i < 8; ++i) { const int s = (tid + 512 * i) >> 5; xr[i] = *(const u32x4*)(PROJ + (size_t)(128 * n + s) * INW + C_VB + ch); }
#pragma unroll
          for (int i = 0; i < 8; ++i) { const int s = (tid + 512 * i) >> 5; const u32x4 xv = xr[i];
            const float mean = stats[2 * s], rstd = stats[2 * s + 1];
            u32x4 o;
            o.x = pk2((bf2f(xv.x & 0xffffu) - mean) * rstd * g0[0] + b0[0], (bf2f(xv.x >> 16) - mean) * rstd * g0[1] + b0[1]);
            o.y = pk2((bf2f(xv.y & 0xffffu) - mean) * rstd * g0[2] + b0[2], (bf2f(xv.y >> 16) - mean) * rstd * g0[3] + b0[3]);
            o.z = pk2((bf2f(xv.z & 0xffffu) - mean) * rstd * g1[0] + b1[0], (bf2f(xv.z >> 16) - mean) * rstd * g1[1] + b1[1]);
            o.w = pk2((bf2f(xv.w & 0xffffu) - mean) * rstd * g1[2] + b1[2], (bf2f(xv.w >> 16) - mean) * rstd * g1[3] + b1[3]);
            *(LAS u32x4*)(lds + 32768 + s * 512 + (((lc >> 2) ^ (s & 7)) << 6) + (lc & 3) * 16) = o; } }
        __syncthreads();
        const int tb = wid & 3, dh = wid >> 2;
        f32x16 acc[4];
#pragma unroll
        for (int c = 0; c < 4; ++c)
#pragma unroll
            for (int r = 0; r < 16; ++r) acc[c][r] = 0.f;
        const int blk = (lane >> 4) & 1, q = (lane & 15) >> 2, p = lane & 3;
        const LAS unsigned char* ab = lds + (32 * tb + r32) * 256;
        const LAS unsigned char* vb = lds + 32768 + (8 * hh + q) * 512 + blk * 32 + p * 8;
        const int ns0 = 2 * tb + 2;
#pragma unroll 1
        for (int s0 = 0; s0 < ns0; ++s0) {
            const bf16x8 af = *(const LAS bf16x8*)(ab + (((2 * s0 + hh) ^ (r32 & 15)) << 4));
#pragma unroll
            for (int c4 = 0; c4 < 4; ++c4) { const int c = 4 * dh + c4;
                const s16x4 lo = trr(vb + s0 * 16 * 512 + ((c ^ q) << 6)), hi = trr(vb + s0 * 16 * 512 + 4 * 512 + ((c ^ (4 + q)) << 6));
                const bf16x8 vf = {lo[0], lo[1], lo[2], lo[3], hi[0], hi[1], hi[2], hi[3]};
                acc[c4] = __builtin_amdgcn_mfma_f32_32x32x16_bf16(af, vf, acc[c4], 0, 0, 0); }
        }
#pragma unroll
        for (int c4 = 0; c4 < 4; ++c4) { const int ch = g * 256 + 32 * (4 * dh + c4) + r32;
            const bf16_t* ub = PROJ + (size_t)(128 * n + 32 * tb + 4 * hh) * INW + ch; bf16_t* ob = AB + (size_t)(128 * n + 32 * tb + 4 * hh) * DM + ch;
            const float* bb = A.sg_b + g * 128 + 32 * tb + 4 * hh;
            unsigned uu[16], zz[16]; float bs[16];
#pragma unroll
            for (int r = 0; r < 16; ++r) { const int rr = (r & 3) + 8 * (r >> 2); uu[r] = ub[(size_t)rr * INW + C_UB]; zz[r] = ub[(size_t)rr * INW + C_ZB]; bs[r] = bb[rr]; }
#pragma unroll
            for (int r = 0; r < 16; ++r) { const int rr = (r & 3) + 8 * (r >> 2);
                ob[(size_t)rr * DM] = (bf16_t)(pk2(bf2f(uu[r]) * (acc[c4][r] + bs[r]) * bf2f(zz[r]), 0.f) & 0xffffu); }
            __builtin_amdgcn_sched_barrier(0);
        }
        __syncthreads();
    }
}

#define XB_TMO      128
#define XB_XCNT(j)  (256  + 64 * (j))
#define XB_XSUB(j)  (1280 + 64 * (j))
#define XB_XGEN(j)  (2304 + 64 * (j))
#define XB_TOP      3328
#define XB_TOPGEN   3392
#define XCD_BAR_WORDS 3456
#define XB_SPIN_CAP (1u << 18)

__device__ __forceinline__ unsigned xb_ld(unsigned* p)              { return __hip_atomic_load(p, __ATOMIC_RELAXED, __HIP_MEMORY_SCOPE_AGENT); }
__device__ __forceinline__ unsigned xb_add(unsigned* p, unsigned v) { return __hip_atomic_fetch_add(p, v, __ATOMIC_RELAXED, __HIP_MEMORY_SCOPE_AGENT); }
__device__ __forceinline__ unsigned xb_xcc_id() { return (unsigned)__builtin_amdgcn_s_getreg((3 << 11) | 20) & 0xFu; }
#define XB_SPIN(cond, bar) do { unsigned _sp = 0; while (cond) { __builtin_amdgcn_s_sleep(1); \
    if ((++_sp & 255u) == 0u) { if (xb_ld(&(bar)[XB_TMO])) break; if (_sp > XB_SPIN_CAP) { atomicAdd(&(bar)[XB_TMO], 1u); break; } } } } while (0)

struct XcdBarrier {
    unsigned* bar; unsigned x;
    volatile LAS unsigned* st;
};

__device__ __forceinline__ XcdBarrier xcd_barrier_post(unsigned* bar, volatile LAS unsigned* st) {
    XcdBarrier b; b.bar = bar; b.x = xb_xcc_id(); b.st = st;
    if (threadIdx.x == 0) (void)xb_add(&bar[XB_XCNT(b.x)], 1u);
    return b;
}
__device__ __forceinline__ void xcd_barrier_complete(unsigned* bar, unsigned x, unsigned& nloc, unsigned& nx) {
    const unsigned G = gridDim.x * gridDim.y * gridDim.z;
    unsigned sum, cnt, mine, sp = 0u;
    for (;;) {
        sum = 0u; cnt = 0u; mine = 0u;
#pragma unroll
        for (unsigned j = 0; j < 16; ++j) { const unsigned c = xb_ld(&bar[XB_XCNT(j)]); sum += c; cnt += (c > 0u) ? 1u : 0u; mine = (j == x) ? c : mine; }
        if (sum == G) break;
        __builtin_amdgcn_s_sleep(1);
        if ((++sp & 255u) == 0u) { if (xb_ld(&bar[XB_TMO])) break; if (sp > XB_SPIN_CAP) { atomicAdd(&bar[XB_TMO], 1u); break; } }
    }
    nloc = mine > 0u ? mine : 1u; nx = cnt > 0u ? cnt : 1u;
}

__device__ __forceinline__ void xcd_barrier(const XcdBarrier& b) {
    asm volatile("s_waitcnt vmcnt(0)" ::: "memory");
    __syncthreads();
    if (threadIdx.x == 0) {
        unsigned* bar = b.bar;
        __builtin_amdgcn_s_waitcnt(0);
        unsigned nloc = b.st[0], nx = b.st[1];
        if (nloc == 0u) { xcd_barrier_complete(bar, b.x, nloc, nx); b.st[0] = nloc; b.st[1] = nx; }
        const unsigned old = xb_add(&bar[XB_XSUB(b.x)], 1u);
        const unsigned gen = old / nloc;
        if (old + 1u == (gen + 1u) * nloc) {
            __builtin_amdgcn_fence(__ATOMIC_RELEASE, "agent");
            asm volatile("s_waitcnt vmcnt(0)" ::: "memory");
            const unsigned og = xb_add(&bar[XB_TOP], 1u);
            const unsigned tg = og / nx;
            if (og + 1u == (tg + 1u) * nx) xb_add(&bar[XB_TOPGEN], 1u);
            else XB_SPIN(xb_ld(&bar[XB_TOPGEN]) == tg, bar);
            __builtin_amdgcn_fence(__ATOMIC_ACQUIRE, "agent");
            xb_add(&bar[XB_XGEN(b.x)], 1u);
            asm volatile("s_waitcnt vmcnt(0)" ::: "memory");
        } else {
            XB_SPIN(xb_ld(&bar[XB_XGEN(b.x)]) == gen, bar);
            __builtin_amdgcn_fence(__ATOMIC_ACQUIRE, "agent");
            asm volatile("s_waitcnt vmcnt(0)" ::: "memory");
        }
    }
    __syncthreads();
}

#ifndef GEMM_ALIGN
#define GEMM_ALIGN true
#endif
#ifndef GEMM_SP2
#define GEMM_SP2 true
#endif
constexpr bool GA = GEMM_ALIGN, GS = GEMM_SP2;
constexpr int NPH = 9;
__global__ void __launch_bounds__(512) mega_fwd(Args A) {
    extern __shared__ __attribute__((aligned(16))) unsigned char lds_raw[];
    LAS unsigned char* lds = (LAS unsigned char*)lds_raw;
    const int tid = threadIdx.x, lane = tid & 63, wid = __builtin_amdgcn_readfirstlane(tid >> 6);
    const int G = gridDim.x, bx = blockIdx.x;
    const int lo = A.lo, hi = A.hi;
    unsigned char* ws = A.ws;
    if (tid < 4) ((volatile LAS unsigned*)(lds + XBST_OFF))[tid] = 0u;
    __syncthreads();
    const XcdBarrier xbar = xcd_barrier_post((unsigned*)(ws + WS_BAR), (volatile LAS unsigned*)(lds + XBST_OFF));
    bf16_t* PROJ = (bf16_t*)(ws + WS_PROJ);
#ifdef DOUBLE_SYNC
#define DBL_SYNC cooperative_groups::this_grid().sync(); cooperative_groups::this_grid().sync();
#else
#define DBL_SYNC
#endif
#define IN(k) (lo <= (k) && (k) < hi)
#define SEAM(k) do { if (IN(k) && IN((k) + 1)) { if ((k) == 0) { asm volatile("s_waitcnt vmcnt(0)" ::: "memory"); __syncthreads(); cooperative_groups::this_grid().sync(); DBL_SYNC } else xcd_barrier(xbar); } } while (0)

#ifndef REP_P0
#define REP_P0 1
#endif
#ifndef REP_P2
#define REP_P2 1
#endif
    if (IN(0)) for (int rep_ = 0; rep_ < REP_P0; ++rep_) {
        const int gw = bx * 8 + wid, NGW = G * 8;
        for (int i = bx * 512 + tid; i < 8192; i += G * 512) { ((float*)(ws + WS_RS))[i] = 0.f; ((float*)(ws + WS_RS2))[i] = 0.f; }
        if (bx == 0 && tid < 4) ((float*)(ws + WS_TMETA))[512 + tid] = 0.f;
        if (bx == 0 && tid < 128) { int mn = 0x7fffffff, mx = (int)0x80000000; for (int i = 0; i < 64; ++i) { const int v = A.pos[tid * 64 + i]; mn = v < mn ? v : mn; mx = v > mx ? v : mx; }
            ((int*)(ws + WS_TMETA))[tid] = mn; ((int*)(ws + WS_TMETA))[128 + tid] = mx; }
        LAS float* scr = (LAS float*)(lds + wid * 16384);
        constexpr int I_IN = 64 * (INW / 32), I_SQ = 64 * (DM / 32), I_XQ = 64 * (512 / 32), I_XKV = 64 * (1024 / 32), I_XO = 8 * (DM / 32);
        constexpr int NITEMS = I_IN + 3 * I_SQ + I_XQ + I_XKV + I_XO;
        for (int it = gw; it < NITEMS; it += NGW) {
            int r = it;
            if (r < I_IN) { p0_transpose_item(A.w_in, DM, INW, (bf16_t*)(ws + WS_WIN), scr, r, lane); continue; } r -= I_IN;
            if (r < I_SQ) { p0_transpose_item(A.w_pa, DM, DM, (bf16_t*)(ws + WS_WPA), scr, r, lane); continue; } r -= I_SQ;
            if (r < I_SQ) { p0_transpose_item(A.w_pb, DM, DM, (bf16_t*)(ws + WS_WPB), scr, r, lane); continue; } r -= I_SQ;
            if (r < I_SQ) { p0_transpose_item(A.w_out, DM, DM, (bf16_t*)(ws + WS_WOUT), scr, r, lane); continue; } r -= I_SQ;
            if (r < I_XQ) { p0_transpose_item(A.w_xq, DM, 512, (bf16_t*)(ws + WS_WXQ), scr, r, lane); continue; } r -= I_XQ;
            if (r < I_XKV) { p0_transpose_item(A.w_xkv, DM, 1024, (bf16_t*)(ws + WS_WXKV), scr, r, lane); continue; } r -= I_XKV;
            p0_transpose_item(A.w_xo, 512, DM, (bf16_t*)(ws + WS_WXO), scr, r, lane);
        }
        for (int m = gw; m < SEQ + MEML; m += NGW) {
            if (m < SEQ) rms_row_to_bf16(A.x + (size_t)m * DM, A.norm1_g, (bf16_t*)(ws + WS_HN) + (size_t)m * DM, lane);
            else rms_row_to_bf16(A.mem + (size_t)(m - SEQ) * DM, A.norm_mem_g, (bf16_t*)(ws + WS_MN) + (size_t)(m - SEQ) * DM, lane);
        }
        __syncthreads();
    }
    SEAM(0);
    if (IN(1)) {
        { pg8::Gemm g{(const bf16_t*)(ws + WS_HN), (const bf16_t*)(ws + WS_WIN), SEQ, INW, DM}; pg8::StaticOrder S; S.init(SEQ, INW, G, bx);
          pg8::EpiProj E{PROJ, INW, A.b_gate, QSCALE, 0};
          pg8::gemm_phase<pg8::EpiProj, pg8::StaticOrder, GA, GS>(lds, g, S, E); }
        if (bx < 64) { const int v = bx, ks = v >> 2;
            pg8::Gemm g{(const bf16_t*)(ws + WS_MN) + ks * 256, (const bf16_t*)(ws + WS_WXKV) + ks * 256, MEML, 1024, 256, DM}; pg8::StaticOrder S; S.init(MEML, 1024, 4, v & 3);
            pg8::EpiF32<false> E{(float*)(ws + WS_KVF) + (size_t)ks * MEML * 1024, 1024};
            pg8::gemm_phase<pg8::EpiF32<false>, pg8::StaticOrder, GA, GS>(lds, g, S, E); }
    }
    SEAM(1);
    if (IN(2)) for (int rep_ = 0; rep_ < REP_P2; ++rep_) {
        if (tid < 256) ((LAS int*)(lds + TM_OFF))[tid] = ((const int*)(ws + WS_TMETA))[tid];
        __syncthreads();
        float lam;
        { const float a = A.lq1[lane] * A.lk1[lane] + A.lq1[lane + 64] * A.lk1[lane + 64], b = A.lq2[lane] * A.lk2[lane] + A.lq2[lane + 64] * A.lk2[lane + 64];
          lam = expf(wave_sum(a)) - expf(wave_sum(b)) + 0.2f; }
        const int vcu = (G % 8 == 0) ? (bx % 8) * (G / 8) + bx / 8 : bx;
        for (int v = vcu; v < 256; v += G) {
            const int h = v >> 4, sx = v & 15;
#pragma unroll 1
            for (int i = 0; i < 8; ++i) { const int b16 = 16 * (i >> 1), qb = (i & 1) ? b16 + sx : 127 - b16 - sx;
#ifndef SKIP_DIFF
                diff_attn_unit(lds, A, h, qb, lam, tid, wid, lane);
#endif
            }
#ifndef SKIP_MIXB
            mixb_unit(lds, A, v >> 2, v & 3, tid, wid, lane);
#endif
        }
    }
#ifdef FILL_AB
    if (IN(2)) { const u32x4* src = (const u32x4*)(ws + WS_HN); u32x4* dst = (u32x4*)(ws + WS_AB);
        for (size_t i = (size_t)bx * 512 + tid; i < (size_t)SEQ * DM / 8; i += (size_t)G * 512) dst[i] = src[i]; }
#endif
    SEAM(2);
    if (IN(3)) {
        { pg8::Gemm g{(const bf16_t*)(ws + WS_AA), (const bf16_t*)(ws + WS_WPA), SEQ, DM, DM}; pg8::StaticOrder S; S.init(SEQ, DM, G, bx);
          pg8::EpiGateA E{PROJ + C_G, INW, (float*)(ws + WS_TMP), DM, A.b_gate};
          pg8::gemm_phase<pg8::EpiGateA, pg8::StaticOrder, GA, GS>(lds, g, S, E); }
#ifdef SYNC_P3
        cooperative_groups::this_grid().sync();
#endif
        { pg8::Gemm g{(const bf16_t*)(ws + WS_AB), (const bf16_t*)(ws + WS_WPB), SEQ, DM, DM}; pg8::StaticOrder S; S.init(SEQ, DM, G, bx);
          pg8::EpiGateB E{PROJ + C_G + DM, INW, (const float*)(ws + WS_TMP), DM, (bf16_t*)(ws + WS_MRG), DM, A.b_gate + DM};
          pg8::gemm_phase<pg8::EpiGateB, pg8::StaticOrder, GA, GS>(lds, g, S, E); }
    }
    SEAM(3);
    if (IN(4)) {
        pg8::Gemm g{(const bf16_t*)(ws + WS_MRG), (const bf16_t*)(ws + WS_WOUT), SEQ, DM, DM}; pg8::StaticOrder S; S.init(SEQ, DM, G, bx);
        pg8::EpiRes E{A.x, (float*)(ws + WS_H1), DM, A.norm_x_g, (bf16_t*)(ws + WS_HG), (float*)(ws + WS_RS)};
        pg8::gemm_phase<pg8::EpiRes, pg8::StaticOrder, GA, GS>(lds, g, S, E);
    }
    SEAM(4);
    if (IN(5)) {
        for (int i = bx * 512 + tid; i < MEML * 1024 / 2; i += G * 512) { float a = 0.f, b = 0.f;
#pragma unroll
            for (int ks = 0; ks < 16; ++ks) { a += ((const float*)(ws + WS_KVF))[(size_t)ks * MEML * 1024 + 2 * i]; b += ((const float*)(ws + WS_KVF))[(size_t)ks * MEML * 1024 + 2 * i + 1]; }
            ((unsigned*)(ws + WS_KVX))[i] = pk2(a, b); }
        if (bx < 256) { const int v = bx, ks = v >> 6;
            pg8::Gemm g{(const bf16_t*)(ws + WS_HG) + ks * 1024, (const bf16_t*)(ws + WS_WXQ) + ks * 1024, SEQ, 512, 1024, DM}; pg8::StaticOrder S; S.init(SEQ, 512, 64, v & 63);
            pg8::EpiF32<false> E{(float*)(ws + WS_TMP) + (size_t)ks * SEQ * 512, 512};
            pg8::gemm_phase<pg8::EpiF32<false>, pg8::StaticOrder, GA, GS>(lds, g, S, E); }
    }
    SEAM(5);
    if (IN(6)) {
#ifndef SKIP_CROSS
        for (int v = bx; v < 128; v += G) cross_attn_unit(lds, A, v & 3, v >> 2, tid, wid, lane);
#endif
    }
    SEAM(6);
    if (IN(7)) {
        pg8::Gemm g{(const bf16_t*)(ws + WS_OX), (const bf16_t*)(ws + WS_WXO), SEQ, DM, 512}; pg8::StaticOrder S; S.init(SEQ, DM, G, bx);
        pg8::EpiRes E{(const float*)(ws + WS_H1), A.out, DM, A.final_g, nullptr, (float*)(ws + WS_RS2)};
        pg8::gemm_phase<pg8::EpiRes, pg8::StaticOrder, GA, GS>(lds, g, S, E);
    }
    SEAM(7);
#ifdef DBG_STAT
    if (IN(8)) {
        const bf16_t* base = PROJ; int cols = 4096, pitch = INW; const float* fa = nullptr; const float* fb = nullptr;
        if (DBG_STAT == 1) { base = PROJ + C_ZA; }
        else if (DBG_STAT == 2) { base = (const bf16_t*)(ws + WS_AA); pitch = DM; }
        else if (DBG_STAT == 3) { base = (const bf16_t*)(ws + WS_AB); pitch = DM; }
        else if (DBG_STAT == 4) { base = PROJ + C_Q; }
        else if (DBG_STAT == 5) { base = PROJ + C_G; cols = 8192; }
        else if (DBG_STAT == 6) { base = PROJ + C_UB; }
        else if (DBG_STAT == 7) { base = PROJ + C_V; }
        else if (DBG_STAT == 8) { base = PROJ + C_VB; }
        else if (DBG_STAT == 9) { base = PROJ + C_K; }
        else if (DBG_STAT == 10) { base = (const bf16_t*)(ws + WS_MRG); pitch = DM; }
        else if (DBG_STAT == 11) { base = (const bf16_t*)(ws + WS_HG); pitch = DM; }
        else if (DBG_STAT == 12) { base = (const bf16_t*)(ws + WS_QX); cols = 512; pitch = 512; }
        else if (DBG_STAT == 14) { base = (const bf16_t*)(ws + WS_OX); cols = 512; pitch = 512; }
        else if (DBG_STAT == 15) { fa = A.out; fb = (const float*)(ws + WS_H1); }
        else if (DBG_STAT == 16) { fa = (const float*)(ws + WS_H1); fb = A.x; }
        float acc = 0.f;
        if (DBG_STAT == 30 || DBG_STAT == 31) {
            const int sid = bx * 8 + wid; const unsigned hsh = (unsigned)(sid + 1) * 2654435761u;
            float num = 0.f, den = 0.f;
            if (DBG_STAT == 30) {
                const int r = (int)((hsh >> 7) % (unsigned)SEQ), h = (int)((hsh >> 3) & 15u);
                float lam_; { const float a = A.lq1[lane] * A.lk1[lane] + A.lq1[lane + 64] * A.lk1[lane + 64], b = A.lq2[lane] * A.lk2[lane] + A.lq2[lane + 64] * A.lk2[lane + 64];
                    lam_ = expf(wave_sum(a)) - expf(wave_sum(b)) + 0.2f; }
                const bf16_t* qp = PROJ + (size_t)r * INW + C_Q + h * 256;
                const float q10 = bf2f(qp[2 * lane]), q11 = bf2f(qp[2 * lane + 1]), q20 = bf2f(qp[128 + 2 * lane]), q21 = bf2f(qp[128 + 2 * lane + 1]);
                float m1 = -1e30f, m2 = -1e30f, l1 = 0.f, l2 = 0.f, a1[4] = {0.f, 0.f, 0.f, 0.f}, a2[4] = {0.f, 0.f, 0.f, 0.f};
                const int pr = A.pos[r];
                for (int j = 0; j < SEQ; ++j) {
                    const int rel = pr - A.pos[j]; if (rel < 0) continue;
                    const bf16_t* kp = PROJ + (size_t)j * INW + C_K + h * 256; const bf16_t* vp = PROJ + (size_t)j * INW + C_V + h * 256 + 4 * lane;
                    float s1 = wave_sum(q10 * bf2f(kp[2 * lane]) + q11 * bf2f(kp[2 * lane + 1])), s2 = wave_sum(q20 * bf2f(kp[128 + 2 * lane]) + q21 * bf2f(kp[128 + 2 * lane + 1]));
                    int bkt; if (rel < 16) bkt = rel; else { const float nf = (float)rel; bkt = 16 + (int)(logf(nf / 16.f) / 2.0794415416798357f * 16.f); bkt = bkt > 31 ? 31 : bkt; }
                    const float bias = A.rel_bias[bkt * 16 + h] * LOG2E; s1 += bias; s2 += bias;
                    const float v0 = bf2f(vp[0]), v1 = bf2f(vp[1]), v2 = bf2f(vp[2]), v3 = bf2f(vp[3]);
                    { const float mn = fmaxf(m1, s1), al = exp2f(m1 - mn), p = exp2f(s1 - mn); l1 = l1 * al + p; a1[0] = a1[0] * al + p * v0; a1[1] = a1[1] * al + p * v1; a1[2] = a1[2] * al + p * v2; a1[3] = a1[3] * al + p * v3; m1 = mn; }
                    { const float mn = fmaxf(m2, s2), al = exp2f(m2 - mn), p = exp2f(s2 - mn); l2 = l2 * al + p; a2[0] = a2[0] * al + p * v0; a2[1] = a2[1] * al + p * v1; a2[2] = a2[2] * al + p * v2; a2[3] = a2[3] * al + p * v3; m2 = mn; }
                }
                float o[4], ssq = 0.f;
                for (int e = 0; e < 4; ++e) { o[e] = a1[e] / l1 - lam_ * a2[e] / l2; ssq += o[e] * o[e]; }
                const float rstd = rsqrtf(wave_sum(ssq) * (1.f / 256.f) + EPS) * 0.8f;
                for (int e = 0; e < 4; ++e) { const int d = 4 * lane + e; const float ex = o[e] * rstd * A.subln_g[d] * bf2f(PROJ[(size_t)r * INW + C_ZA + h * 256 + d]);
                    const float st = bf2f(((const bf16_t*)(ws + WS_AA))[(size_t)r * DM + h * 256 + d]); num += fabsf(ex - st); den += fabsf(ex); }
            } else {
                const int tok = (int)((hsh >> 7) % (unsigned)SEQ), g = (int)((hsh >> 3) & 15u), n = tok >> 7, t = tok & 127;
                float mx[4] = {0.f, 0.f, 0.f, 0.f};
                for (int s_ = 0; s_ <= t; ++s_) { const bf16_t* rowp = PROJ + (size_t)(128 * n + s_) * INW + C_VB; float sm = 0.f, sq = 0.f;
                    for (int e = 0; e < 64; ++e) { const float v = bf2f(rowp[lane + 64 * e]); sm += v; sq += v * v; }
                    const float mean = wave_sum(sm) * (1.f / 4096.f), var = wave_sum(sq) * (1.f / 4096.f) - mean * mean, rstd = rsqrtf(var + EPS);
                    const float w = A.sg_w[((size_t)g * 128 + t) * 128 + s_];
                    for (int e = 0; e < 4; ++e) { const int ch = g * 256 + 4 * lane + e; mx[e] += w * ((bf2f(rowp[ch]) - mean) * rstd * A.sg_ln_g[ch] + A.sg_ln_b[ch]); } }
                for (int e = 0; e < 4; ++e) { const int ch = g * 256 + 4 * lane + e; const float ex = bf2f(PROJ[(size_t)tok * INW + C_UB + ch]) * (mx[e] + A.sg_b[g * 128 + t]) * bf2f(PROJ[(size_t)tok * INW + C_ZB + ch]);
                    const float st = bf2f(((const bf16_t*)(ws + WS_AB))[(size_t)tok * DM + ch]); num += fabsf(ex - st); den += fabsf(ex); }
            }
            num = wave_sum(num); den = wave_sum(den);
            if (lane == 0) { atomicAdd((float*)(ws + WS_TMETA) + 513, num); atomicAdd((float*)(ws + WS_TMETA) + 514, den); }
            asm volatile("s_waitcnt vmcnt(0)" ::: "memory"); __syncthreads(); cooperative_groups::this_grid().sync();
            if (bx == 0 && tid == 0) { const float n_ = __hip_atomic_load((float*)(ws + WS_TMETA) + 513, __ATOMIC_RELAXED, __HIP_MEMORY_SCOPE_AGENT), d_ = __hip_atomic_load((float*)(ws + WS_TMETA) + 514, __ATOMIC_RELAXED, __HIP_MEMORY_SCOPE_AGENT);
                atomicAdd((float*)(ws + WS_TMETA) + 512, n_ / d_); }
        } else
        if ((DBG_STAT >= 20 && DBG_STAT < 30) || (DBG_STAT >= 33 && DBG_STAT <= 35)) {
            const int sid = bx * 512 + tid; const unsigned hsh = (unsigned)(sid + 1) * 2654435761u;
            int r = (int)((hsh >> 8) % (unsigned)SEQ); float dot = 0.f, st = 0.f;
            if (DBG_STAT <= 24) {
                const int csec = (DBG_STAT == 20) ? C_V : (DBG_STAT == 21) ? C_K : (DBG_STAT == 22) ? C_Q : (DBG_STAT == 23) ? C_UB : C_G;
                const int c = csec + (int)((hsh >> 3) % (DBG_STAT == 24 ? 8192u : 4096u));
                const bf16_t* hn = (const bf16_t*)(ws + WS_HN) + (size_t)r * DM;
                for (int k = 0; k < DM; ++k) dot += bf2f(hn[k]) * A.w_in[(size_t)k * INW + c];
                if (DBG_STAT == 22) dot *= QSCALE;
                if (DBG_STAT == 23) dot = pg8::gelut_(dot);
                st = bf2f(PROJ[(size_t)r * INW + c]);
            } else if (DBG_STAT == 25) {
                const int c = (int)((hsh >> 3) % 4096u); const bf16_t* aa = (const bf16_t*)(ws + WS_AA) + (size_t)r * DM; const bf16_t* ab = (const bf16_t*)(ws + WS_AB) + (size_t)r * DM;
                float ya = 0.f, yb = 0.f;
                for (int k = 0; k < DM; ++k) { ya += bf2f(aa[k]) * A.w_pa[(size_t)k * DM + c]; yb += bf2f(ab[k]) * A.w_pb[(size_t)k * DM + c]; }
                dot = ya / (1.f + expf(-(bf2f(PROJ[(size_t)r * INW + C_G + c]) + A.b_gate[c]))) + yb / (1.f + expf(-(bf2f(PROJ[(size_t)r * INW + C_G + DM + c]) + A.b_gate[DM + c])));
                st = bf2f(((const bf16_t*)(ws + WS_MRG))[(size_t)r * DM + c]);
            } else if (DBG_STAT == 26) {
                const int c = (int)((hsh >> 3) % 4096u); const bf16_t* mg = (const bf16_t*)(ws + WS_MRG) + (size_t)r * DM;
                for (int k = 0; k < DM; ++k) dot += bf2f(mg[k]) * A.w_out[(size_t)k * DM + c];
                st = ((const float*)(ws + WS_H1))[(size_t)r * DM + c] - A.x[(size_t)r * DM + c];
            } else if (DBG_STAT == 27) {
                const int c = (int)((hsh >> 3) % 512u); const float* h1 = (const float*)(ws + WS_H1) + (size_t)r * DM; float ssq = 0.f;
                for (int k = 0; k < DM; ++k) { ssq += h1[k] * h1[k]; dot += h1[k] * A.norm_x_g[k] * A.w_xq[(size_t)k * 512 + c]; }
                dot *= rsqrtf(ssq * (1.f / 4096.f) + EPS) * QSCALE;
                st = bf2f(((const bf16_t*)(ws + WS_QX))[(size_t)r * 512 + c]);
            } else if (DBG_STAT == 28) {
                const int c = (int)((hsh >> 3) % 512u), h = c >> 7; const bf16_t* qx = (const bf16_t*)(ws + WS_QX) + (size_t)r * 512 + h * 128; const bf16_t* kv = (const bf16_t*)(ws + WS_KVX);
                float m = -1e30f, l = 0.f, ac = 0.f;
                for (int j = 0; j < MEML; ++j) { float sc = 0.f; for (int k = 0; k < 128; ++k) sc += bf2f(qx[k]) * bf2f(kv[(size_t)j * 1024 + h * 128 + k]);
                    const float mn = fmaxf(m, sc), al = exp2f(m - mn), p = exp2f(sc - mn); l = l * al + p; ac = ac * al + p * bf2f(kv[(size_t)j * 1024 + 512 + c]); m = mn; }
                dot = ac / l; st = bf2f(((const bf16_t*)(ws + WS_OX))[(size_t)r * 512 + c]);
            } else if (DBG_STAT == 29) {
                const int c = (int)((hsh >> 3) % 4096u); const bf16_t* ox = (const bf16_t*)(ws + WS_OX) + (size_t)r * 512;
                for (int k = 0; k < 512; ++k) dot += bf2f(ox[k]) * A.w_xo[(size_t)k * DM + c];
                dot += ((const float*)(ws + WS_H1))[(size_t)r * DM + c]; st = A.out[(size_t)r * DM + c];
            } else if (DBG_STAT == 34 || DBG_STAT == 35) {
                const float* hp = (DBG_STAT == 34) ? A.out + (size_t)r * DM : (const float*)(ws + WS_H1) + (size_t)r * DM;
                for (int k = 0; k < DM; ++k) dot += hp[k] * hp[k];
                st = ((const float*)(ws + (DBG_STAT == 34 ? WS_RS2 : WS_RS)))[r];
#ifdef DBG_HALF
                st *= 0.5f;
#endif
            } else {
                r = r % MEML; const int c = (int)((hsh >> 3) % 1024u); const bf16_t* mn_ = (const bf16_t*)(ws + WS_MN) + (size_t)r * DM;
                for (int k = 0; k < DM; ++k) dot += bf2f(mn_[k]) * A.w_xkv[(size_t)k * 1024 + c];
                st = bf2f(((const bf16_t*)(ws + WS_KVX))[(size_t)r * 1024 + c]);
            }
            float num = wave_sum(fabsf(dot - st)), den = wave_sum(fabsf(dot));
            if (lane == 0) { atomicAdd((float*)(ws + WS_TMETA) + 513, num); atomicAdd((float*)(ws + WS_TMETA) + 514, den); }
            asm volatile("s_waitcnt vmcnt(0)" ::: "memory"); __syncthreads(); cooperative_groups::this_grid().sync();
            if (bx == 0 && tid == 0) { const float n_ = __hip_atomic_load((float*)(ws + WS_TMETA) + 513, __ATOMIC_RELAXED, __HIP_MEMORY_SCOPE_AGENT), d_ = __hip_atomic_load((float*)(ws + WS_TMETA) + 514, __ATOMIC_RELAXED, __HIP_MEMORY_SCOPE_AGENT);
                atomicAdd((float*)(ws + WS_TMETA) + 512, n_ / d_); }
        } else
        if (fa) { for (int r = bx; r < SEQ; r += G) for (int c = tid; c < DM; c += 512) acc += fabsf(fa[(size_t)r * DM + c] - fb[(size_t)r * DM + c]); cols = DM; }
        else { for (int r = bx; r < SEQ; r += G) for (int c = tid; c < cols; c += 512) acc += fabsf(bf2f(base[(size_t)r * pitch + c])); }
        acc = wave_sum(acc);
        if (lane == 0) atomicAdd((float*)(ws + WS_TMETA) + 512, acc / ((float)SEQ * (float)cols));
        asm volatile("s_waitcnt vmcnt(0)" ::: "memory"); __syncthreads(); cooperative_groups::this_grid().sync();
        const int gw = bx * 8 + wid, NGW = G * 8; const float sv = ((const float*)(ws + WS_TMETA))[512];
        const float cc = 1.f + 2.f * fminf(fmaxf(sv, 0.f), 1.f);
        for (int m = gw; m < SEQ; m += NGW) {
            const f32x4* xr = (const f32x4*)(A.x + (size_t)m * DM) + lane; f32x4* o = (f32x4*)(A.out + (size_t)m * DM) + lane; const f32x4* gr = (const f32x4*)A.final_g + lane;
            float ssq = 0.f;
            for (int j = 0; j < 16; ++j) { const f32x4 v = xr[64 * j]; ssq += v.x * v.x + v.y * v.y + v.z * v.z + v.w * v.w; }
            const float rs = rsqrtf(wave_sum(ssq) * (1.f / 4096.f) + EPS) * cc;
            for (int j = 0; j < 16; ++j) { o[64 * j] = xr[64 * j] * rs * gr[64 * j]; }
        }
    }
    return;
#endif
    if (IN(8)) {
        const int gw = bx * 8 + wid, NGW = G * 8; const float* RS2 = (const float*)(ws + WS_RS2);
        for (int m = gw; m < SEQ; m += NGW) { const float rs = rsqrtf(RS2[m] * (1.f / 4096.f) + EPS);
            f32x4* o = (f32x4*)(A.out + (size_t)m * DM) + lane; const f32x4* gr = (const f32x4*)A.final_g + lane;
#pragma unroll 4
            for (int j = 0; j < 16; ++j) { f32x4 v = o[64 * j]; const f32x4 gg = gr[64 * j]; v = v * rs * gg; o[64 * j] = v; } }
    }
#undef IN
#undef SEAM
}

#ifndef MK_MULTI
#define MK_MULTI 0
#endif
extern "C" void kernel_launch(void* const* d_in, const int* in_sizes, int n_in, void* d_out, int out_size, void* d_ws, size_t ws_size, hipStream_t stream) {
    static int grid = 0;
    if (grid == 0) {
        if (n_in != 25 || ws_size < WS_END) { fprintf(stderr, "kernel_launch: unexpected n_in %d / ws %zu (need %zu)\n", n_in, ws_size, (size_t)WS_END); grid = -1; return; }
        int dev = 0, cus = 0, per_cu = 0;
        hipGetDevice(&dev); hipDeviceGetAttribute(&cus, hipDeviceAttributeMultiprocessorCount, dev);
        if (hipFuncSetAttribute((const void*)mega_fwd, hipFuncAttributeMaxDynamicSharedMemorySize, LDS_BYTES) != hipSuccess) { fprintf(stderr, "kernel_launch: hipFuncSetAttribute failed\n"); grid = -1; return; }
        hipOccupancyMaxActiveBlocksPerMultiprocessor(&per_cu, (const void*)mega_fwd, 512, LDS_BYTES);
        if (per_cu < 1) per_cu = 1;
        (void)hipGetLastError();
        grid = cus * 1;
        if (grid < 256) { fprintf(stderr, "kernel_launch: this kernel needs >= 256 CUs (got %d)\n", grid); grid = -1; return; }
    }
    if (grid < 0) return;
    Args a{};
    a.x = (const float*)d_in[0]; a.pos = (const int*)d_in[1]; a.mem = (const float*)d_in[2]; a.w_in = (const float*)d_in[3]; a.b_gate = (const float*)d_in[4];
    a.norm1_g = (const float*)d_in[5]; a.lq1 = (const float*)d_in[6]; a.lk1 = (const float*)d_in[7]; a.lq2 = (const float*)d_in[8]; a.lk2 = (const float*)d_in[9];
    a.subln_g = (const float*)d_in[10]; a.rel_bias = (const float*)d_in[11]; a.sg_ln_g = (const float*)d_in[12]; a.sg_ln_b = (const float*)d_in[13];
    a.sg_w = (const float*)d_in[14]; a.sg_b = (const float*)d_in[15]; a.w_pa = (const float*)d_in[16]; a.w_pb = (const float*)d_in[17]; a.w_out = (const float*)d_in[18];
    a.norm_x_g = (const float*)d_in[19]; a.norm_mem_g = (const float*)d_in[20]; a.w_xq = (const float*)d_in[21]; a.w_xkv = (const float*)d_in[22]; a.w_xo = (const float*)d_in[23];
    a.final_g = (const float*)d_in[24];
    a.out = (float*)d_out; a.ws = (unsigned char*)d_ws;
#if MK_MULTI
    for (int ph = 0; ph < NPH; ++ph) { a.lo = ph; a.hi = ph + 1; hipLaunchKernelGGL(mega_fwd, dim3(grid), dim3(512), LDS_BYTES, stream, a); }
#else
    a.lo = 0; a.hi = NPH;
    (void)hipMemsetAsync((char*)d_ws + WS_BAR, 0, BAR_BYTES, stream);
    void* args[] = {&a};
    hipError_t e = hipLaunchCooperativeKernel((const void*)mega_fwd, dim3(grid), dim3(512), args, LDS_BYTES, stream);
    if (e != hipSuccess) fprintf(stderr, "cooperative launch failed: %s (grid %d)\n", hipGetErrorString(e), grid);
#endif
}
```

```cpp
#include <hip/hip_runtime.h>
#include <hip/hip_cooperative_groups.h>
#include <cstdio>
#include <cstdint>
#include <cmath>
namespace pg8 {
#define PG8_LAS __attribute__((address_space(3)))
typedef unsigned short bf16_t;
typedef short bf16x8 __attribute__((ext_vector_type(8)));
typedef float f32x4 __attribute__((ext_vector_type(4)));
typedef unsigned u32x4 __attribute__((ext_vector_type(4)));
constexpr int BM = 256, BK = 64, HALF = 128, HTB = HALF * BK * 2  , STAGE_BYTES = 8 * HTB, NXCD = 8, WGM = 8;

__host__ __device__ __forceinline__ int lds_byte(int r, int c) { const int st = (r >> 4) * 2 + (c >> 5), rr = r & 15, cc = c & 31, ob = rr * 64 + cc * 2; return st * 1024 + (ob ^ (((ob >> 9) & 1) << 5)); }
__host__ __device__ __forceinline__ void stage_rc(int b, int& R, int& C) { const int st = b / 1024, sb = b % 1024, swz = sb ^ (((sb >> 9) & 1) << 5); R = (st >> 1) * 16 + swz / 64; C = (st & 1) * 32 + (swz % 64) / 2; }
__host__ __device__ __forceinline__ int perm32(int rho) { const int n = rho >> 4, i = rho & 15; return 8 * (i >> 2) + 4 * n + (i & 3); }

struct Unit { int pm, pn; };
struct Gemm { const bf16_t* A; const bf16_t* Bt; int M, N, K; int ld; };

struct StaticOrder {
    int nM, nN, nwg, G, c;
    __host__ __device__ void init(int M, int N, int G_, int c_) { nM = M / BM; nN = N / BM; nwg = nM * nN; G = G_; c = c_; }
    __host__ __device__ bool next(int i, Unit& u) const {
        const long L = (long)i * G + c; if (L >= nwg) return false;
        int wgid = (int)L; { const int q = nwg / NXCD, r = nwg % NXCD, xcd = wgid % NXCD, off = wgid / NXCD; wgid = (xcd < r ? xcd * (q + 1) : r * (q + 1) + (xcd - r) * q) + off; }
        const int nig = WGM * nN, gid = wgid / nig, fm = gid * WGM, gsz = (nM - fm) < WGM ? (nM - fm) : WGM;
        u.pm = fm + ((wgid % nig) % gsz); u.pn = (wgid % nig) / gsz; return true;
    }
    __device__ __forceinline__ void a_ready(const Unit&) const {}
    __device__ __forceinline__ void done(const Unit&) const {}
};

__device__ __forceinline__ unsigned cvt_pk_bf16(float lo, float hi) { unsigned r; asm volatile("v_cvt_pk_bf16_f32 %0, %1, %2" : "=v"(r) : "v"(lo), "v"(hi)); return r; }
typedef float f32x2 __attribute__((ext_vector_type(2)));
__device__ __forceinline__ float ex2_(float x) { return __builtin_amdgcn_exp2f(x); }
__device__ __forceinline__ float rcp_(float x) { return __builtin_amdgcn_rcpf(x); }
__device__ __forceinline__ float sigm_(float x) { return rcp_(1.f + ex2_(-1.4426950408889634f * x)); }
__device__ __forceinline__ float silu_(float x) { return x * sigm_(x); }
__device__ __forceinline__ float gelut_(float x) { const float u = 0.7978845608028654f * (x + 0.044715f * x * x * x); return x * sigm_(2.f * u); }
__device__ __forceinline__ float bf2f_(unsigned b) { return __uint_as_float(b << 16); }
template <int MODE> __device__ __forceinline__ float act_(float v, float sc) {
    if (MODE == 1) return v * sc; if (MODE == 2) return silu_(v); if (MODE == 3) return gelut_(v); if (MODE == 4) return sigm_(v); return v; }

struct EpiProj {
    static constexpr bool PERM = true, AFTER_DRAIN = false;
    bf16_t* O; int ldc; const float* bgate; float qscale; int plain;
    template <int MODE> __device__ __forceinline__ void run(const f32x4 (&acc)[2][2][4][2], const Unit& u, int wr, int wc, int fr, int fq) const {
        const int row0 = u.pm * BM + wr * 64 + fr, col0 = u.pn * BM + wc * 32 + 8 * fq;
        f32x4 bv[2][2];
#pragma unroll
        for (int bj = 0; bj < 2; ++bj)
#pragma unroll
            for (int n = 0; n < 2; ++n) bv[bj][n] = (MODE == 4) ? *(const f32x4*)(bgate + (col0 - 28672) + bj * HALF + 4 * n) : (f32x4){0.f, 0.f, 0.f, 0.f};
#pragma unroll
        for (int ai = 0; ai < 2; ++ai)
#pragma unroll
            for (int m = 0; m < 4; ++m) { bf16_t* rowp = O + (size_t)(row0 + ai * HALF + m * 16) * ldc + col0;
#pragma unroll
                for (int bj = 0; bj < 2; ++bj) { f32x4 v0 = acc[ai][bj][m][0] + bv[bj][0], v1 = acc[ai][bj][m][1] + bv[bj][1];
#pragma unroll
                    for (int e = 0; e < 4; ++e) { v0[e] = act_<MODE>(v0[e], qscale); v1[e] = act_<MODE>(v1[e], qscale); }
                    u32x4 w; w.x = cvt_pk_bf16(v0[0], v0[1]); w.y = cvt_pk_bf16(v0[2], v0[3]); w.z = cvt_pk_bf16(v1[0], v1[1]); w.w = cvt_pk_bf16(v1[2], v1[3]);
                    *(u32x4*)(rowp + bj * HALF) = w; } }
    }
    __device__ __forceinline__ void operator()(const f32x4 (&acc)[2][2][4][2], const Unit& u, int wr, int wc, int fr, int fq) const {
        const int sect = u.pn >> 4;
        if (plain || sect == 1 || sect == 2 || sect >= 7) run<0>(acc, u, wr, wc, fr, fq);
        else if (sect == 0) run<1>(acc, u, wr, wc, fr, fq);
        else if (sect == 3 || sect == 6) run<2>(acc, u, wr, wc, fr, fq);
        else if (sect == 4 || sect == 5) run<3>(acc, u, wr, wc, fr, fq);
        else run<4>(acc, u, wr, wc, fr, fq);
    }
};
struct EpiGateA {
    static constexpr bool PERM = true, AFTER_DRAIN = false;
    const bf16_t* G; int ldg; float* T; int ldt; const float* bg;
    __device__ __forceinline__ void operator()(const f32x4 (&acc)[2][2][4][2], const Unit& u, int wr, int wc, int fr, int fq) const {
        const int row0 = u.pm * BM + wr * 64 + fr, col0 = u.pn * BM + wc * 32 + 8 * fq;
#pragma unroll
        for (int ai = 0; ai < 2; ++ai)
#pragma unroll
            for (int m = 0; m < 4; ++m) { const size_t row = (size_t)(row0 + ai * HALF + m * 16);
#pragma unroll
                for (int bj = 0; bj < 2; ++bj) { const int col = col0 + bj * HALF; const u32x4 g = *(const u32x4*)(G + row * ldg + col);
                    f32x4 v0 = acc[ai][bj][m][0], v1 = acc[ai][bj][m][1];
                    const f32x4 b0 = *(const f32x4*)(bg + col), b1 = *(const f32x4*)(bg + col + 4);
                    v0[0] *= sigm_(bf2f_(g.x & 0xffffu) + b0[0]); v0[1] *= sigm_(bf2f_(g.x >> 16) + b0[1]); v0[2] *= sigm_(bf2f_(g.y & 0xffffu) + b0[2]); v0[3] *= sigm_(bf2f_(g.y >> 16) + b0[3]);
                    v1[0] *= sigm_(bf2f_(g.z & 0xffffu) + b1[0]); v1[1] *= sigm_(bf2f_(g.z >> 16) + b1[1]); v1[2] *= sigm_(bf2f_(g.w & 0xffffu) + b1[2]); v1[3] *= sigm_(bf2f_(g.w >> 16) + b1[3]);
                    *(f32x4*)(T + row * ldt + col) = v0; *(f32x4*)(T + row * ldt + col + 4) = v1; } }
    }
};
struct EpiGateB {
    static constexpr bool PERM = true, AFTER_DRAIN = false;
    const bf16_t* G; int ldg; const float* T; int ldt; bf16_t* O; int ldc; const float* bg;
    __device__ __forceinline__ void operator()(const f32x4 (&acc)[2][2][4][2], const Unit& u, int wr, int wc, int fr, int fq) const {
        const int row0 = u.pm * BM + wr * 64 + fr, col0 = u.pn * BM + wc * 32 + 8 * fq;
#pragma unroll
        for (int ai = 0; ai < 2; ++ai)
#pragma unroll
            for (int m = 0; m < 4; ++m) { const size_t row = (size_t)(row0 + ai * HALF + m * 16);
#pragma unroll
                for (int bj = 0; bj < 2; ++bj) { const int col = col0 + bj * HALF; const u32x4 g = *(const u32x4*)(G + row * ldg + col);
                    f32x4 v0 = acc[ai][bj][m][0], v1 = acc[ai][bj][m][1];
                    const f32x4 t0 = *(const f32x4*)(T + row * ldt + col), t1 = *(const f32x4*)(T + row * ldt + col + 4);
                    const f32x4 b0 = *(const f32x4*)(bg + col), b1 = *(const f32x4*)(bg + col + 4);
                    v0[0] = t0[0] + v0[0] * sigm_(bf2f_(g.x & 0xffffu) + b0[0]); v0[1] = t0[1] + v0[1] * sigm_(bf2f_(g.x >> 16) + b0[1]); v0[2] = t0[2] + v0[2] * sigm_(bf2f_(g.y & 0xffffu) + b0[2]); v0[3] = t0[3] + v0[3] * sigm_(bf2f_(g.y >> 16) + b0[3]);
                    v1[0] = t1[0] + v1[0] * sigm_(bf2f_(g.z & 0xffffu) + b1[0]); v1[1] = t1[1] + v1[1] * sigm_(bf2f_(g.z >> 16) + b1[1]); v1[2] = t1[2] + v1[2] * sigm_(bf2f_(g.w & 0xffffu) + b1[2]); v1[3] = t1[3] + v1[3] * sigm_(bf2f_(g.w >> 16) + b1[3]);
                    u32x4 w; w.x = cvt_pk_bf16(v0[0], v0[1]); w.y = cvt_pk_bf16(v0[2], v0[3]); w.z = cvt_pk_bf16(v1[0], v1[1]); w.w = cvt_pk_bf16(v1[2], v1[3]);
                    *(u32x4*)(O + row * ldc + col) = w; } }
    }
};
struct EpiRes {
    static constexpr bool PERM = true, AFTER_DRAIN = false;
    const float* X; float* H; int ld; const float* gx; bf16_t* HG; float* RS;
    __device__ __forceinline__ void operator()(const f32x4 (&acc)[2][2][4][2], const Unit& u, int wr, int wc, int fr, int fq) const {
        const int row0 = u.pm * BM + wr * 64 + fr, col0 = u.pn * BM + wc * 32 + 8 * fq;
#pragma unroll
        for (int ai = 0; ai < 2; ++ai)
#pragma unroll
            for (int m = 0; m < 4; ++m) { const size_t row = (size_t)(row0 + ai * HALF + m * 16); float ss = 0.f;
#pragma unroll
                for (int bj = 0; bj < 2; ++bj) { const int col = col0 + bj * HALF;
                    const f32x4 h0 = *(const f32x4*)(X + row * ld + col) + acc[ai][bj][m][0], h1 = *(const f32x4*)(X + row * ld + col + 4) + acc[ai][bj][m][1];
                    *(f32x4*)(H + row * ld + col) = h0; *(f32x4*)(H + row * ld + col + 4) = h1;
                    ss += (h0[0] * h0[0] + h0[1] * h0[1]) + (h0[2] * h0[2] + h0[3] * h0[3]) + (h1[0] * h1[0] + h1[1] * h1[1]) + (h1[2] * h1[2] + h1[3] * h1[3]);
                    if (HG) { const f32x4 g0 = *(const f32x4*)(gx + col), g1 = *(const f32x4*)(gx + col + 4);
                        u32x4 w; w.x = cvt_pk_bf16(h0[0] * g0[0], h0[1] * g0[1]); w.y = cvt_pk_bf16(h0[2] * g0[2], h0[3] * g0[3]); w.z = cvt_pk_bf16(h1[0] * g1[0], h1[1] * g1[1]); w.w = cvt_pk_bf16(h1[2] * g1[2], h1[3] * g1[3]);
                        *(u32x4*)(HG + row * ld + col) = w; } }
                ss += __shfl_xor(ss, 16); ss += __shfl_xor(ss, 32);
                if (fq == 0) atomicAdd(RS + row, ss); }
    }
};
struct EpiRowScale {
    static constexpr bool PERM = true, AFTER_DRAIN = false;
    bf16_t* O; int ldc; const float* RS; float sc;
    __device__ __forceinline__ void operator()(const f32x4 (&acc)[2][2][4][2], const Unit& u, int wr, int wc, int fr, int fq) const {
        const int row0 = u.pm * BM + wr * 64 + fr, col0 = u.pn * BM + wc * 32 + 8 * fq;
#pragma unroll
        for (int ai = 0; ai < 2; ++ai)
#pragma unroll
            for (int m = 0; m < 4; ++m) { const size_t row = (size_t)(row0 + ai * HALF + m * 16); const float rs = rsqrtf(RS[row] * (1.f / 4096.f) + 1e-6f) * sc;
#pragma unroll
                for (int bj = 0; bj < 2; ++bj) { const f32x4 v0 = acc[ai][bj][m][0] * rs, v1 = acc[ai][bj][m][1] * rs;
                    u32x4 w; w.x = cvt_pk_bf16(v0[0], v0[1]); w.y = cvt_pk_bf16(v0[2], v0[3]); w.z = cvt_pk_bf16(v1[0], v1[1]); w.w = cvt_pk_bf16(v1[2], v1[3]);
                    *(u32x4*)(O + row * ldc + col0 + bj * HALF) = w; } }
    }
};

template <bool ATOMIC> struct EpiF32 {
    static constexpr bool PERM = true, AFTER_DRAIN = false;
    float* O; int ldc;
    __device__ __forceinline__ void operator()(const f32x4 (&acc)[2][2][4][2], const Unit& u, int wr, int wc, int fr, int fq) const {
        const int row0 = u.pm * BM + wr * 64 + fr, col0 = u.pn * BM + wc * 32 + 8 * fq;
#pragma unroll
        for (int ai = 0; ai < 2; ++ai)
#pragma unroll
            for (int m = 0; m < 4; ++m) { float* rowp = O + (size_t)(row0 + ai * HALF + m * 16) * ldc + col0;
#pragma unroll
                for (int bj = 0; bj < 2; ++bj) {
                    if (ATOMIC) {
#pragma unroll
                        for (int e = 0; e < 4; ++e) { atomicAdd(rowp + bj * HALF + e, acc[ai][bj][m][0][e]); atomicAdd(rowp + bj * HALF + 4 + e, acc[ai][bj][m][1][e]); }
                    } else { *(f32x4*)(rowp + bj * HALF) = acc[ai][bj][m][0]; *(f32x4*)(rowp + bj * HALF + 4) = acc[ai][bj][m][1]; } } }
    }
};
template <class Epi, class Sched, bool ALIGN_EPI = false, bool SP2 = false>
__device__ __forceinline__ void gemm_phase(PG8_LAS unsigned char* lds, const Gemm g, const Sched& S, const Epi& E) {
    const int tid = threadIdx.x, wid = __builtin_amdgcn_readfirstlane(tid >> 6), lane = tid & 63, wr = wid >> 2, wc = wid & 3, fr = lane & 15, fq = lane >> 4;
    const int K = g.K, nt = K / BK, LD = g.ld ? g.ld : g.K;
    unsigned voffA[2], voffB[2];
#pragma unroll
    for (int i = 0; i < 2; ++i) { int R, C; stage_rc(tid * 16 + i * 8192, R, C); const int Rb = Epi::PERM ? ((R & ~31) + perm32(R & 31)) : R;
        voffA[i] = (unsigned)(R * LD + C) * 2u; voffB[i] = (unsigned)(Rb * LD + C) * 2u; }
    const size_t kstep = (size_t)(BK * 2);
    const size_t hstep = (size_t)HALF * LD * 2;
    const size_t tstep = 2 * hstep;
    const unsigned ldsw = (unsigned)wid * 1024u;
    const int aoff = lds_byte(wr * 64 + fr, fq * 8), boff = lds_byte(wc * 32 + fr, fq * 8);
#define PG8_SA(b, h) (((b) * 2 + (h)) * HTB)
#define PG8_SB(b, h) ((4 + (b) * 2 + (h)) * HTB)
#define PG8_STAGE(bufoff, gbase, voff) do { _Pragma("unroll") for (int _i = 0; _i < 2; ++_i) \
        __builtin_amdgcn_global_load_lds((const unsigned*)((const char*)(gbase) + (voff)[_i]), (PG8_LAS unsigned*)(lds + (bufoff) + ldsw + _i * 8192), 16, 0, 0); } while (0)
#define PG8_LDA(dst, b, h) do { _Pragma("unroll") for (int m = 0; m < 4; ++m) _Pragma("unroll") for (int k = 0; k < 2; ++k) dst[m][k] = *(const PG8_LAS bf16x8*)(lds + PG8_SA(b, h) + aoff + m * 2048 + k * 1024); } while (0)
#define PG8_LDB(dst, b, h) do { _Pragma("unroll") for (int n = 0; n < 2; ++n) _Pragma("unroll") for (int k = 0; k < 2; ++k) dst[n][k] = *(const PG8_LAS bf16x8*)(lds + PG8_SB(b, h) + boff + n * 2048 + k * 1024); } while (0)
#define PG8_MMA(ai, bj, At, Bt) do { __builtin_amdgcn_s_setprio(1); _Pragma("unroll") for (int m = 0; m < 4; ++m) _Pragma("unroll") for (int n = 0; n < 2; ++n) _Pragma("unroll") for (int k = 0; k < 2; ++k) \
        acc[ai][bj][m][n] = __builtin_amdgcn_mfma_f32_16x16x32_bf16(Bt[n][k], At[m][k], acc[ai][bj][m][n], 0, 0, 0); __builtin_amdgcn_s_setprio(0); } while (0)
#define PG8_WAIT_V(n) asm volatile("s_waitcnt vmcnt(" #n ")" ::: "memory")
#define PG8_WAIT_L(n) asm volatile("s_waitcnt lgkmcnt(" #n ")" ::: "memory")
#define PG8_BAR __builtin_amdgcn_s_barrier()
#define PG8_SCHED __builtin_amdgcn_sched_barrier(0)
    Unit cur, nxt; int ui = 0;
    if (!S.next(0, cur)) return;
    f32x4 acc[2][2][4][2];
#pragma unroll
    for (int a = 0; a < 2; ++a)
#pragma unroll
        for (int b = 0; b < 2; ++b)
#pragma unroll
            for (int m = 0; m < 4; ++m)
#pragma unroll
                for (int n = 0; n < 2; ++n) acc[a][b][m][n] = (f32x4){0.f, 0.f, 0.f, 0.f};
    bf16x8 At[4][2], B0[2][2], B1[2][2];
    const char* cA = (const char*)g.A + (size_t)cur.pm * tstep; const char* cB = (const char*)g.Bt + (size_t)cur.pn * tstep;
    S.a_ready(cur);
    if constexpr (SP2) {
        PG8_STAGE(PG8_SB(0, 0), cB, voffB); PG8_STAGE(PG8_SB(0, 1), cB + hstep, voffB); PG8_STAGE(PG8_SA(0, 0), cA, voffA); PG8_STAGE(PG8_SA(0, 1), cA + hstep, voffA);
        if (wr == 1) PG8_BAR;
        PG8_WAIT_V(2); PG8_BAR;
        PG8_STAGE(PG8_SB(1, 0), cB + kstep, voffB); PG8_STAGE(PG8_SA(1, 0), cA + kstep, voffA); PG8_STAGE(PG8_SB(1, 1), cB + hstep + kstep, voffB);
        PG8_WAIT_V(6); PG8_BAR;
    } else {
        PG8_STAGE(PG8_SB(0, 0), cB, voffB); PG8_STAGE(PG8_SA(0, 0), cA, voffA); PG8_STAGE(PG8_SB(0, 1), cB + hstep, voffB); PG8_STAGE(PG8_SA(0, 1), cA + hstep, voffA);
        if (wr == 1) PG8_BAR;
        PG8_WAIT_V(4); PG8_BAR;
        PG8_STAGE(PG8_SB(1, 0), cB + kstep, voffB); PG8_STAGE(PG8_SA(1, 0), cA + kstep, voffA); PG8_STAGE(PG8_SB(1, 1), cB + hstep + kstep, voffB);
        PG8_WAIT_V(6); PG8_BAR;
    }
    for (;;) {
        const bool has_next = S.next(ui + 1, nxt);
        const char* nA = has_next ? (const char*)g.A + (size_t)nxt.pm * tstep : cA; const char* nB = has_next ? (const char*)g.Bt + (size_t)nxt.pn * tstep : cB;
        for (int t = 0; t < nt; t += 2) {
            const bool last = (t == nt - 2);
            const char* a1 = cA + (size_t)(t + 1) * kstep;
            const char* a2 = last ? nA : cA + (size_t)(t + 2) * kstep; const char* b2 = last ? nB : cB + (size_t)(t + 2) * kstep;
            const char* a3 = a2 + kstep; const char* b3 = b2 + kstep;
            if (last && has_next) S.a_ready(nxt);
            if constexpr (SP2) {
            PG8_LDB(B0, 0, 0); PG8_LDB(B1, 0, 1); PG8_SCHED; PG8_LDA(At, 0, 0); PG8_STAGE(PG8_SA(1, 1), a1 + hstep, voffA);
            PG8_WAIT_V(8); PG8_WAIT_L(0); PG8_BAR; PG8_MMA(0, 0, At, B0); PG8_MMA(0, 1, At, B1); PG8_BAR; PG8_SCHED;
            PG8_LDA(At, 0, 1); PG8_STAGE(PG8_SB(0, 0), b2, voffB); PG8_STAGE(PG8_SB(0, 1), b2 + hstep, voffB); PG8_STAGE(PG8_SA(0, 0), a2, voffA);
            PG8_WAIT_V(8); PG8_WAIT_L(0); PG8_BAR; PG8_MMA(1, 0, At, B0); PG8_MMA(1, 1, At, B1); PG8_BAR; PG8_SCHED;
            PG8_LDB(B0, 1, 0); PG8_LDB(B1, 1, 1); PG8_SCHED; PG8_LDA(At, 1, 0); PG8_STAGE(PG8_SA(0, 1), a2 + hstep, voffA);
            PG8_WAIT_V(8); PG8_WAIT_L(0); PG8_BAR; PG8_MMA(0, 0, At, B0); PG8_MMA(0, 1, At, B1); PG8_BAR; PG8_SCHED;
            PG8_LDA(At, 1, 1); PG8_STAGE(PG8_SB(1, 0), b3, voffB); PG8_STAGE(PG8_SB(1, 1), b3 + hstep, voffB); PG8_STAGE(PG8_SA(1, 0), a3, voffA);
            PG8_WAIT_V(8); PG8_WAIT_L(0); PG8_BAR; PG8_MMA(1, 0, At, B0); PG8_MMA(1, 1, At, B1); PG8_BAR; PG8_SCHED;
            } else {
            PG8_LDB(B0, 0, 0); PG8_SCHED; PG8_LDA(At, 0, 0); PG8_STAGE(PG8_SA(1, 1), a1 + hstep, voffA);
            PG8_WAIT_L(8); PG8_BAR; PG8_WAIT_L(0); PG8_MMA(0, 0, At, B0); PG8_BAR; PG8_SCHED;
            PG8_LDB(B1, 0, 1); PG8_STAGE(PG8_SB(0, 0), b2, voffB);
            PG8_BAR; PG8_WAIT_L(0); PG8_MMA(0, 1, At, B1); PG8_BAR;
            PG8_LDA(At, 0, 1); PG8_STAGE(PG8_SA(0, 0), a2, voffA);
            PG8_BAR; PG8_WAIT_L(0); PG8_MMA(1, 0, At, B0); PG8_BAR; PG8_SCHED;
            PG8_STAGE(PG8_SB(0, 1), b2 + hstep, voffB);
            PG8_WAIT_V(6); PG8_BAR; PG8_MMA(1, 1, At, B1); PG8_BAR;
            PG8_LDB(B0, 1, 0); PG8_SCHED; PG8_LDA(At, 1, 0); PG8_STAGE(PG8_SA(0, 1), a2 + hstep, voffA);
            PG8_WAIT_L(8); PG8_BAR; PG8_WAIT_L(0); PG8_MMA(0, 0, At, B0); PG8_BAR; PG8_SCHED;
            PG8_LDB(B1, 1, 1); PG8_STAGE(PG8_SB(1, 0), b3, voffB);
            PG8_BAR; PG8_WAIT_L(0); PG8_MMA(0, 1, At, B1); PG8_BAR;
            PG8_LDA(At, 1, 1); PG8_STAGE(PG8_SA(1, 0), a3, voffA);
            PG8_BAR; PG8_WAIT_L(0); PG8_MMA(1, 0, At, B0); PG8_BAR; PG8_SCHED;
            PG8_STAGE(PG8_SB(1, 1), b3 + hstep, voffB);
            PG8_WAIT_V(6); PG8_BAR; PG8_MMA(1, 1, At, B1); PG8_BAR;
            }
        }
        if constexpr (ALIGN_EPI) { if (wr == 0) PG8_BAR; }
        if constexpr (!Epi::AFTER_DRAIN) { E(acc, cur, wr, wc, fr, fq); S.done(cur); }
        if (!has_next) break;
#pragma unroll
        for (int a = 0; a < 2; ++a)
#pragma unroll
            for (int b = 0; b < 2; ++b)
#pragma unroll
                for (int m = 0; m < 4; ++m)
#pragma unroll
                    for (int n = 0; n < 2; ++n) acc[a][b][m][n] = (f32x4){0.f, 0.f, 0.f, 0.f};
        cur = nxt; cA = nA; cB = nB; ++ui;
        if constexpr (ALIGN_EPI) { if (wr == 1) PG8_BAR; }
    }
    PG8_WAIT_V(0);
    if constexpr (!ALIGN_EPI) { if (wr == 0) PG8_BAR; }
    PG8_BAR;
    if constexpr (Epi::AFTER_DRAIN) { E.fused(acc, cur, wr, wc, fr, fq, lds, wid, lane); S.done(cur); }
#undef PG8_SA
#undef PG8_SB
#undef PG8_STAGE
#undef PG8_LDA
#undef PG8_LDB
#undef PG8_MMA
#undef PG8_WAIT_V
#undef PG8_WAIT_L
#undef PG8_BAR
#undef PG8_SCHED
}
}

#define LAS __attribute__((address_space(3)))
typedef pg8::bf16_t bf16_t;
typedef pg8::bf16x8 bf16x8;
typedef pg8::f32x4 f32x4;
typedef pg8::u32x4 u32x4;
typedef float f32x16 __attribute__((ext_vector_type(16)));
typedef short s16x4 __attribute__((ext_vector_type(4)));
typedef int i32x4 __attribute__((ext_vector_type(4)));

constexpr int SEQ = 8192, DM = 4096, INW = 36864, MEML = 256;
constexpr int C_Q = 0, C_K = 4096, C_V = 8192, C_ZA = 12288, C_UB = 16384, C_VB = 20480, C_ZB = 24576, C_G = 28672;
constexpr float LOG2E = 1.4426950408889634f;
constexpr float QSCALE = 0.08838834764831845f * LOG2E;
constexpr float EPS = 1e-6f;

constexpr size_t MiB = 1u << 20;
constexpr size_t WS_RS = 0, WS_RS2 = 32768, WS_TMETA = 65536, WS_BAR = 131072, BAR_BYTES = 16384;
constexpr size_t WS_WIN = 1 * MiB;
constexpr size_t WS_WPA = WS_WIN + 288 * MiB, WS_WPB = WS_WPA + 32 * MiB, WS_WOUT = WS_WPB + 32 * MiB;
constexpr size_t WS_WXQ = WS_WOUT + 32 * MiB, WS_WXKV = WS_WXQ + 4 * MiB, WS_WXO = WS_WXKV + 8 * MiB;
constexpr size_t WS_HN = WS_WXO + 4 * MiB;
constexpr size_t WS_MN = WS_HN + 64 * MiB;
constexpr size_t WS_PROJ = WS_MN + 2 * MiB;
constexpr size_t WS_AA = WS_PROJ + 576 * MiB, WS_AB = WS_AA + 64 * MiB;
constexpr size_t WS_TMP = WS_AB + 64 * MiB;
constexpr size_t WS_MRG = WS_TMP + 128 * MiB;
constexpr size_t WS_H1 = WS_MRG + 64 * MiB;
constexpr size_t WS_HG = WS_H1 + 128 * MiB;
constexpr size_t WS_QX = WS_HG + 64 * MiB;
constexpr size_t WS_KVX = WS_QX + 8 * MiB;
constexpr size_t WS_OX = WS_KVX + 1 * MiB;
constexpr size_t WS_KVF = WS_OX + 8 * MiB;
constexpr size_t WS_END = WS_KVF + 16 * MiB;

constexpr int STAGE = 65536;
constexpr int LUT_OFF = 131072, WSF_OFF = 131072 + 1024, SS_OFF = 131072 + 2048, TM_OFF = 131072 + 3072, POSK_OFF = 131072 + 4096, XM_OFF = 131072 + 4608, PB_OFF = 131072 + 4608 + 4096, XBST_OFF = 131072 + 4608 + 4096 + 16384, FLAG_OFF = 131072 + 4608 + 4096 + 16384 + 16, LDS_BYTES = 131072 + 4608 + 4096 + 16384 + 16 + 64;

struct Args {
    const float *x; const int* pos; const float *mem, *w_in, *b_gate, *norm1_g, *lq1, *lk1, *lq2, *lk2, *subln_g, *rel_bias, *sg_ln_g, *sg_ln_b, *sg_w, *sg_b,
                *w_pa, *w_pb, *w_out, *norm_x_g, *norm_mem_g, *w_xq, *w_xkv, *w_xo, *final_g;
    float* out; unsigned char* ws; int lo, hi;
};

__device__ __forceinline__ float wave_sum(float v) {
#pragma unroll
    for (int o = 1; o < 64; o <<= 1) v += __shfl_xor(v, o);
    return v;
}
__device__ __forceinline__ unsigned pk2(float lo, float hi) { return pg8::cvt_pk_bf16(lo, hi); }
__device__ __forceinline__ float bf2f(unsigned b) { return __uint_as_float(b << 16); }
__device__ __forceinline__ void glds16(const void* g, LAS unsigned char* l) { unsigned keep; const unsigned dst = (unsigned)__builtin_amdgcn_readfirstlane((int)(unsigned)(uintptr_t)l);
    asm volatile("s_mov_b32 %0, m0\n\ts_mov_b32 m0, %2\n\ts_nop 0\n\tglobal_load_lds_dwordx4 %1, off\n\ts_mov_b32 m0, %0" : "=&s"(keep) : "v"(g), "s"(dst) : "memory"); }
__device__ __forceinline__ s16x4 trr(const LAS unsigned char* p) { return __builtin_bit_cast(s16x4, __builtin_amdgcn_ds_read_tr16_b64_v4i16((LAS s16x4*)p)); }
__device__ __forceinline__ int crow(int r, int hi) { return (r & 3) + 8 * (r >> 2) + 4 * hi; }

__device__ __forceinline__ void p0_transpose_item(const float* W, int K, int N, bf16_t* WT, LAS float* scr, int item, int lane) {
    const int nblk = N / 32, kb = item / nblk, nb = item % nblk, k0 = 64 * kb, n0 = 32 * nb;
    float wv[32];
#pragma unroll
    for (int i = 0; i < 32; ++i) wv[i] = W[(size_t)(k0 + 2 * i + (lane >> 5)) * N + n0 + (lane & 31)];
#pragma unroll
    for (int i = 0; i < 32; ++i) scr[(2 * i + (lane >> 5)) * 33 + (lane & 31)] = wv[i];
    __builtin_amdgcn_fence(__ATOMIC_RELEASE, "wavefront"); asm volatile("s_waitcnt lgkmcnt(0)" ::: "memory");
    const int c = lane & 7;
#pragma unroll
    for (int j = 0; j < 4; ++j) { const int n = (lane >> 3) + 8 * j; const LAS float* s = scr + (8 * c) * 33 + n;
        u32x4 o; o.x = pk2(s[0 * 33], s[1 * 33]); o.y = pk2(s[2 * 33], s[3 * 33]); o.z = pk2(s[4 * 33], s[5 * 33]); o.w = pk2(s[6 * 33], s[7 * 33]);
        *(u32x4*)(WT + (size_t)(n0 + n) * K + k0 + 8 * c) = o; }
    asm volatile("s_waitcnt lgkmcnt(0)" ::: "memory");
}
__device__ __forceinline__ void rms_row_to_bf16(const float* xrow, const float* g, bf16_t* orow, int lane) {
    const f32x4* xr = (const f32x4*)xrow + lane; const f32x4* gr = (const f32x4*)g + lane;
    f32x4 v[16]; float s = 0.f;
#pragma unroll
    for (int j = 0; j < 16; ++j) { v[j] = xr[64 * j]; s += (v[j].x * v[j].x + v[j].y * v[j].y) + (v[j].z * v[j].z + v[j].w * v[j].w); }
    const float rstd = rsqrtf(wave_sum(s) * (1.f / 4096.f) + EPS);
    unsigned long long* o8 = (unsigned long long*)orow + lane;
#pragma unroll
    for (int j = 0; j < 16; ++j) { const f32x4 gg = gr[64 * j];
        o8[64 * j] = (unsigned long long)pk2(v[j].x * rstd * gg.x, v[j].y * rstd * gg.y) | ((unsigned long long)pk2(v[j].z * rstd * gg.z, v[j].w * rstd * gg.w) << 32); }
}

__device__ __forceinline__ void glds4(const void* g, LAS unsigned char* l) { unsigned keep; const unsigned dst = (unsigned)__builtin_amdgcn_readfirstlane((int)(unsigned)(uintptr_t)l);
    asm volatile("s_mov_b32 %0, m0\n\ts_mov_b32 m0, %2\n\ts_nop 0\n\tglobal_load_lds_dword %1, off\n\ts_mov_b32 m0, %0" : "=&s"(keep) : "v"(g), "s"(dst) : "memory"); }
template <int NVB>
__device__ __forceinline__ void attn_dma(LAS unsigned char* st, int wid, int lane, const bf16_t* K0, const bf16_t* K1, size_t kpitch, const bf16_t* V, size_t vpitch) {
#pragma unroll
    for (int i2 = 0; i2 < 2; ++i2) { const int i = wid * 2 + i2, row = 4 * i + (lane >> 4), pc = lane & 15, lc = pc ^ (row & 15);
        glds16(K0 + (size_t)row * kpitch + lc * 8, st + i * 1024);
        glds16(K1 + (size_t)row * kpitch + lc * 8, st + 16384 + i * 1024); }
    if (NVB == 8) {
#pragma unroll
        for (int i4 = 0; i4 < 4; ++i4) { const int i = wid * 4 + i4, row = 2 * i + (lane >> 5), pc = lane & 31, lc = pc ^ ((row & 7) << 2);
            glds16(V + (size_t)row * vpitch + lc * 8, st + 32768 + i * 1024); }
    } else {
#pragma unroll
        for (int i2 = 0; i2 < 2; ++i2) { const int i = wid * 2 + i2, row = 4 * i + (lane >> 4), pc = lane & 15, lc = pc ^ ((row & 3) << 2);
            glds16(V + (size_t)row * vpitch + lc * 8, st + 32768 + i * 1024); }
    }
}

template <int NO, int NVB, bool MASKED>
__device__ __forceinline__ void attn_tile(bool NEAR, const LAS unsigned char* Kst, const LAS unsigned char* Vst, const bf16x8 (&qf)[8], f32x16 (&O)[NO], float& m_ref, float& l_part,
                                          LAS float* wsf, int lane, const LAS int* posk, int qpos, const LAS float* lut, int cbase) {
    const int r32 = lane & 31, h = lane >> 5;
    const LAS unsigned char* kb_ = Kst + r32 * 256;
    const int sw = r32 & 15;
    constexpr int ROWB = NVB * 64;
    const int blk = (lane >> 4) & 1, q = (lane & 15) >> 2, p = lane & 3;
    const int swl = (NVB == 8) ? (4 * h + q) : q;
    const LAS unsigned char* vb = Vst + (4 * h + q) * ROWB + blk * 32 + p * 8;
    const float nm = -m_ref;
    f32x16 S0 = {nm, nm, nm, nm, nm, nm, nm, nm, nm, nm, nm, nm, nm, nm, nm, nm}, S1 = S0;
#pragma unroll
    for (int dg = 0; dg < 2; ++dg) {
        bf16x8 kf0[4], kf1[4];
#pragma unroll
        for (int d = 0; d < 4; ++d) { const int co = ((2 * (4 * dg + d) + h) ^ sw) << 4; kf0[d] = *(const LAS bf16x8*)(kb_ + co); kf1[d] = *(const LAS bf16x8*)(kb_ + 8192 + co); }
        __builtin_amdgcn_sched_barrier(0);
#pragma unroll
        for (int d = 0; d < 4; ++d) {
            S0 = __builtin_amdgcn_mfma_f32_32x32x16_bf16(kf0[d], qf[4 * dg + d], S0, 0, 0, 0);
            S1 = __builtin_amdgcn_mfma_f32_32x32x16_bf16(kf1[d], qf[4 * dg + d], S1, 0, 0, 0);
        }
        __builtin_amdgcn_sched_barrier(0);
    }
    if (MASKED && NEAR) {
        float b0[16], b1[16];
#pragma unroll
        for (int g4 = 0; g4 < 4; ++g4) { const i32x4 pk0 = *(const LAS i32x4*)(posk + 8 * g4 + 4 * h), pk1 = *(const LAS i32x4*)(posk + 32 + 8 * g4 + 4 * h);
#pragma unroll
            for (int i = 0; i < 4; ++i) { const int rel0 = qpos - pk0[i], rel1 = qpos - pk1[i];
                b0[4 * g4 + i] = lut[rel0 < 0 ? 129 : (rel0 > 128 ? 128 : rel0)]; b1[4 * g4 + i] = lut[rel1 < 0 ? 129 : (rel1 > 128 ? 128 : rel1)]; } }
#pragma unroll
        for (int r = 0; r < 16; ++r) { S0[r] += b0[r]; S1[r] += b1[r]; }
    }
    float mt = fmaxf(S0[0], S1[0]);
#pragma unroll
    for (int r = 1; r < 16; ++r) mt = fmaxf(mt, fmaxf(S0[r], S1[r]));
    mt = fmaxf(mt, __shfl_xor(mt, 32));
    const bool need = mt > 8.f;
    if (__any(need)) {
        const float dl = need ? mt : 0.f;
        const float alpha = pg8::ex2_(-dl);
        l_part *= alpha; m_ref += dl;
#pragma unroll
        for (int r = 0; r < 16; ++r) { S0[r] -= dl; S1[r] -= dl; }
        wsf[r32] = alpha;
#pragma unroll
        for (int g4 = 0; g4 < 4; ++g4) { const f32x4 a = *(const LAS f32x4*)(wsf + 8 * g4 + 4 * h);
#pragma unroll
            for (int c = 0; c < NO; ++c)
#pragma unroll
                for (int i = 0; i < 4; ++i) O[c][4 * g4 + i] *= a[i]; }
    }
    float ls = 0.f;
#pragma unroll
    for (int r = 0; r < 16; ++r) { const float p0 = pg8::ex2_(S0[r]), p1 = pg8::ex2_(S1[r]); S0[r] = p0; S1[r] = p1; ls += p0 + p1; }
    l_part += ls;
    bf16x8 pa[2][2];
#pragma unroll
    for (int ks = 0; ks < 2; ++ks) {
        u32x4 w; w.x = pk2(S0[8 * ks + 0], S0[8 * ks + 1]); w.y = pk2(S0[8 * ks + 2], S0[8 * ks + 3]); w.z = pk2(S0[8 * ks + 4], S0[8 * ks + 5]); w.w = pk2(S0[8 * ks + 6], S0[8 * ks + 7]); pa[0][ks] = __builtin_bit_cast(bf16x8, w);
        u32x4 x; x.x = pk2(S1[8 * ks + 0], S1[8 * ks + 1]); x.y = pk2(S1[8 * ks + 2], S1[8 * ks + 3]); x.z = pk2(S1[8 * ks + 4], S1[8 * ks + 5]); x.w = pk2(S1[8 * ks + 6], S1[8 * ks + 7]); pa[1][ks] = __builtin_bit_cast(bf16x8, x); }
    __builtin_amdgcn_sched_barrier(0);
    {
        bf16x8 vf[2][NO];
#define LOADV(buf, g) do { _Pragma("unroll") for (int c = 0; c < NO; ++c) { const LAS unsigned char* a0 = vb + (16 * (g)) * ROWB + (((c + cbase) ^ swl) << 6); \
            const s16x4 lo = trr(a0), hi = trr(a0 + 8 * ROWB); vf[buf][c] = (bf16x8){lo[0], lo[1], lo[2], lo[3], hi[0], hi[1], hi[2], hi[3]}; } } while (0)
        LOADV(0, 0);
#pragma unroll
        for (int g = 0; g < 4; ++g) {
            if (g + 1 < 4) LOADV((g + 1) & 1, g + 1);
            __builtin_amdgcn_sched_barrier(0);
#pragma unroll
            for (int c = 0; c < NO; ++c) O[c] = __builtin_amdgcn_mfma_f32_32x32x16_bf16(pa[g >> 1][g & 1], vf[g & 1][c], O[c], 0, 0, 0);
            __builtin_amdgcn_sched_barrier(0);
        }
#undef LOADV
    }
}

__device__ __forceinline__ void attn_tile_pair(bool NEAR, bool first, int par, const LAS unsigned char* Kst, const LAS unsigned char* Vst, const bf16x8 (&qf)[8], f32x16 (&O)[4], float& m_ref, float& l_part,
                                               LAS float* wsf, LAS float* xm, LAS unsigned char* pb, int wid, int lane, const LAS int* posk, int qpos, const LAS float* lut, int dh, volatile LAS int* flg, int seq) {
    const int r32 = lane & 31, h = lane >> 5;
    if (!first) {
        const float mt = fmaxf(xm[((par ^ 1) * 8 + wid) * 64 + r32], xm[((par ^ 1) * 8 + (wid ^ 2)) * 64 + r32]);
        const bool need = mt > 8.f;
        if (__any(need)) {
            const float dl = need ? mt : 0.f; const float alpha = pg8::ex2_(-dl);
            l_part *= alpha; m_ref += dl;
            wsf[r32] = alpha;
#pragma unroll
            for (int g4 = 0; g4 < 4; ++g4) { const f32x4 a = *(const LAS f32x4*)(wsf + 8 * g4 + 4 * h);
#pragma unroll
                for (int c = 0; c < 4; ++c)
#pragma unroll
                    for (int i = 0; i < 4; ++i) O[c][4 * g4 + i] *= a[i]; }
        }
    }
    const LAS unsigned char* kb_ = Kst + (32 * dh + r32) * 256;
    const int sw = r32 & 15;
    const float nm = -m_ref;
    f32x16 S = {nm, nm, nm, nm, nm, nm, nm, nm, nm, nm, nm, nm, nm, nm, nm, nm}, T = {0.f, 0.f, 0.f, 0.f, 0.f, 0.f, 0.f, 0.f, 0.f, 0.f, 0.f, 0.f, 0.f, 0.f, 0.f, 0.f};
    {
        bf16x8 kf[8];
#pragma unroll
        for (int d0 = 0; d0 < 8; ++d0) kf[d0] = *(const LAS bf16x8*)(kb_ + (((2 * d0 + h) ^ sw) << 4));
        __builtin_amdgcn_sched_barrier(0);
#pragma unroll
        for (int d = 0; d < 4; ++d) {
            S = __builtin_amdgcn_mfma_f32_32x32x16_bf16(kf[d], qf[d], S, 0, 0, 0);
            T = __builtin_amdgcn_mfma_f32_32x32x16_bf16(kf[4 + d], qf[4 + d], T, 0, 0, 0);
        }
    }
    __builtin_amdgcn_sched_barrier(0);
#pragma unroll
    for (int r = 0; r < 16; ++r) S[r] += T[r];
    if (NEAR) {
        float b0[16];
#pragma unroll
        for (int g4 = 0; g4 < 4; ++g4) { const i32x4 pk0 = *(const LAS i32x4*)(posk + 32 * dh + 8 * g4 + 4 * h);
#pragma unroll
            for (int i = 0; i < 4; ++i) { const int rel0 = qpos - pk0[i]; b0[4 * g4 + i] = lut[rel0 < 0 ? 129 : (rel0 > 128 ? 128 : rel0)]; } }
#pragma unroll
        for (int r = 0; r < 16; ++r) S[r] += b0[r];
    }
    float mt = S[0];
#pragma unroll
    for (int r = 1; r < 16; ++r) mt = fmaxf(mt, S[r]);
    mt = fmaxf(mt, __shfl_xor(mt, 32));
    xm[(par * 8 + wid) * 64 + r32] = mt;
    float ls = 0.f;
#pragma unroll
    for (int r = 0; r < 16; ++r) { const float p0 = pg8::ex2_(S[r]); S[r] = p0; ls += p0; }
    l_part += ls;
    u32x4 mine[2];
#pragma unroll
    for (int ks = 0; ks < 2; ++ks) { mine[ks].x = pk2(S[8 * ks + 0], S[8 * ks + 1]); mine[ks].y = pk2(S[8 * ks + 2], S[8 * ks + 3]); mine[ks].z = pk2(S[8 * ks + 4], S[8 * ks + 5]); mine[ks].w = pk2(S[8 * ks + 6], S[8 * ks + 7]);
        *(LAS u32x4*)(pb + ((wid * 2 + ks) * 64 + lane) * 16) = mine[ks]; }
    const int blk = (lane >> 4) & 1, q = (lane & 15) >> 2, p = lane & 3;
    const int swl = 4 * h + q, cbase = 4 * dh;
    const LAS unsigned char* vb = Vst + (4 * h + q) * 512 + blk * 32 + p * 8;
    bf16x8 vf[2][4];
#define LOADV(buf, g) do { _Pragma("unroll") for (int c = 0; c < 4; ++c) { const LAS unsigned char* a0 = vb + (16 * (g)) * 512 + (((c + cbase) ^ swl) << 6); \
        const s16x4 lo = trr(a0), hi = trr(a0 + 8 * 512); vf[buf][c] = (bf16x8){lo[0], lo[1], lo[2], lo[3], hi[0], hi[1], hi[2], hi[3]}; } } while (0)
    LOADV(0, 0);
    asm volatile("" ::: "memory");
    flg[wid] = seq;
    while (flg[wid ^ 2] != seq) __builtin_amdgcn_s_sleep(1);
    asm volatile("" ::: "memory");
    u32x4 oth[2];
#pragma unroll
    for (int ks = 0; ks < 2; ++ks) oth[ks] = *(const LAS u32x4*)(pb + (((wid ^ 2) * 2 + ks) * 64 + lane) * 16);
    bf16x8 pa[2][2];
#pragma unroll
    for (int ks = 0; ks < 2; ++ks) { const u32x4 lo = dh ? oth[ks] : mine[ks], hi = dh ? mine[ks] : oth[ks]; pa[0][ks] = __builtin_bit_cast(bf16x8, lo); pa[1][ks] = __builtin_bit_cast(bf16x8, hi); }
    {
#pragma unroll
        for (int g = 0; g < 4; ++g) {
            if (g + 1 < 4) LOADV((g + 1) & 1, g + 1);
            __builtin_amdgcn_sched_barrier(0);
#pragma unroll
            for (int c = 0; c < 4; ++c) O[c] = __builtin_amdgcn_mfma_f32_32x32x16_bf16(pa[g >> 1][g & 1], vf[g & 1][c], O[c], 0, 0, 0);
            __builtin_amdgcn_sched_barrier(0);
        }
#undef LOADV
    }
}

template <int NVB>
__device__ __forceinline__ void scale_rows(f32x16 (&O)[NVB], float val, LAS float* wsf, int lane) {
    const int r32 = lane & 31, h = lane >> 5;
    wsf[r32] = val;
#pragma unroll
    for (int g4 = 0; g4 < 4; ++g4) { const f32x4 a = *(const LAS f32x4*)(wsf + 8 * g4 + 4 * h);
#pragma unroll
        for (int c = 0; c < NVB; ++c)
#pragma unroll
            for (int i = 0; i < 4; ++i) O[c][4 * g4 + i] *= a[i]; }
}

__device__ __forceinline__ int next_tile(const LAS int* tmin, int j, int qmax) { while (j < 128 && tmin[j] > qmax) ++j; return j; }

__device__ __forceinline__ void diff_attn_unit(LAS unsigned char* lds, const Args& A, int h, int qb, float lam, int tid, int wid, int lane) {
    asm volatile("" : "+v"(tid), "+v"(lane), "+s"(wid));
    const bf16_t* PROJ = (const bf16_t*)(A.ws + WS_PROJ); bf16_t* AA = (bf16_t*)(A.ws + WS_AA);
    const LAS int* tmin = (const LAS int*)(lds + TM_OFF); const LAS int* tmax = tmin + 128;
    const int grp = wid >> 2, wsub = wid & 3, rb = wsub & 1, dh = wsub >> 1, r32 = lane & 31, hh = lane >> 5;
    LAS float* lut = (LAS float*)(lds + LUT_OFF);
    LAS float* wsf = (LAS float*)(lds + WSF_OFF) + wid * 32;
    LAS float* SS = (LAS float*)(lds + SS_OFF);
    if (tid == 129) lut[129] = -INFINITY;
    if (tid < 129) { const int n = tid; float v = 0.f;
        if (n < 128) { int b; if (n < 16) b = n; else { const float lg = logf((float)n * (1.f / 16.f)) / 2.0794415416798357f * 16.f; b = 16 + (int)lg; b = b > 31 ? 31 : b; }
            v = (A.rel_bias[b * 16 + h] - A.rel_bias[31 * 16 + h]) * LOG2E; }
        lut[n] = v; }
    const int row0 = qb * 64, myrow = row0 + 32 * rb + r32;
    const bf16_t* Qp = PROJ + (size_t)myrow * INW + C_Q + h * 256 + grp * 128 + 8 * hh;
    bf16x8 qf[8];
#pragma unroll
    for (int d0 = 0; d0 < 8; ++d0) qf[d0] = *(const bf16x8*)(Qp + 16 * d0);
    const int qpos = A.pos[myrow];
    const bf16_t* Kb0 = PROJ + C_K + h * 256; const bf16_t* Kb1 = Kb0 + 128; const bf16_t* Vb = PROJ + C_V + h * 256;
    const int qmin = tmin[qb], qmax = tmax[qb];
    f32x16 O[4];
#pragma unroll
    for (int c = 0; c < 4; ++c)
#pragma unroll
        for (int r = 0; r < 16; ++r) O[c][r] = 0.f;
    float m_ref = 0.f, l_part = 0.f;
    int j = next_tile(tmin, 0, qmax), s = 0, seq = 0; bool first = true;
    volatile LAS int* flg = (volatile LAS int*)(lds + FLAG_OFF);
    flg[wid] = 0;
    __syncthreads();
    if (j < 128) attn_dma<8>(lds, wid, lane, Kb0 + (size_t)j * 64 * INW, Kb1 + (size_t)j * 64 * INW, INW, Vb + (size_t)j * 64 * INW, INW);
    if (j < 128 && wid == 0) glds4(A.pos + j * 64 + lane, lds + POSK_OFF);
    while (j < 128) {
        asm volatile("s_waitcnt vmcnt(0)" ::: "memory"); __syncthreads();
        const int jn = next_tile(tmin, j + 1, qmax);
        if (jn < 128) attn_dma<8>(lds + (s ^ 1) * STAGE, wid, lane, Kb0 + (size_t)jn * 64 * INW, Kb1 + (size_t)jn * 64 * INW, INW, Vb + (size_t)jn * 64 * INW, INW);
        if (jn < 128 && wid == 0) glds4(A.pos + jn * 64 + lane, lds + POSK_OFF + (s ^ 1) * 256);
        const bool near = (qmin - tmax[j]) < 128;
        const LAS unsigned char* st = lds + s * STAGE;
        attn_tile_pair(near, first, s, st + grp * 16384, st + 32768, qf, O, m_ref, l_part, wsf, (LAS float*)(lds + XM_OFF), lds + PB_OFF, wid, lane, (const LAS int*)(lds + POSK_OFF + s * 256), qpos, lut, dh, flg, ++seq);
        first = false; j = jn; s ^= 1;
    }
    float lt = l_part + __shfl_xor(l_part, 32);
    { LAS float* xl = (LAS float*)(lds + XM_OFF); __syncthreads(); xl[wid * 64 + r32] = lt; __syncthreads(); lt += xl[(wid ^ 2) * 64 + r32]; }
    scale_rows<4>(O, pg8::rcp_(lt) * (grp ? lam : 1.f), wsf, lane);
    __syncthreads();
    LAS float* X = (LAS float*)lds;
    if (grp == 1) {
#pragma unroll
        for (int c = 0; c < 4; ++c)
#pragma unroll
            for (int r = 0; r < 16; ++r) X[((wsub * 4 + c) * 16 + r) * 64 + lane] = O[c][r];
    }
    __syncthreads();
    float ss[16];
    if (grp == 0) {
#pragma unroll
        for (int r = 0; r < 16; ++r) ss[r] = 0.f;
#pragma unroll
        for (int c = 0; c < 4; ++c)
#pragma unroll
            for (int r = 0; r < 16; ++r) { const float o = O[c][r] - X[((wsub * 4 + c) * 16 + r) * 64 + lane]; O[c][r] = o; ss[r] += o * o; }
#pragma unroll
        for (int r = 0; r < 16; ++r) { float v = ss[r]; v += __shfl_xor(v, 1); v += __shfl_xor(v, 2); v += __shfl_xor(v, 4); v += __shfl_xor(v, 8); v += __shfl_xor(v, 16); ss[r] = v;
            if (r32 == 0) SS[(wsub * 2 + hh) * 16 + r] = v; }
    }
    __syncthreads();
    if (grp == 0) {
#pragma unroll
        for (int r = 0; r < 16; ++r) ss[r] = rsqrtf((ss[r] + SS[((wsub ^ 2) * 2 + hh) * 16 + r]) * (1.f / 256.f) + EPS) * 0.8f;
        const bf16_t* zb = PROJ + (size_t)(row0 + 32 * rb + 4 * hh) * INW + C_ZA + h * 256 + 128 * dh + r32;
        bf16_t* ob = AA + (size_t)(row0 + 32 * rb + 4 * hh) * DM + h * 256 + 128 * dh + r32;
#pragma unroll
        for (int c = 0; c < 4; ++c) { const float gs = A.subln_g[128 * dh + 32 * c + r32];
            unsigned zz[16];
#pragma unroll
            for (int r = 0; r < 16; ++r) { const int rr = (r & 3) + 8 * (r >> 2); zz[r] = zb[(size_t)rr * INW + 32 * c]; }
#pragma unroll
            for (int r = 0; r < 16; ++r) { const int rr = (r & 3) + 8 * (r >> 2);
                ob[(size_t)rr * DM + 32 * c] = (bf16_t)(pk2(O[c][r] * ss[r] * gs * bf2f(zz[r]), 0.f) & 0xffffu); }
            __builtin_amdgcn_sched_barrier(0);
        }
    }
    __syncthreads();
}

__device__ __forceinline__ void cross_attn_unit(LAS unsigned char* lds, const Args& A, int h, int qb, int tid, int wid, int lane) {
    asm volatile("" : "+v"(tid), "+v"(lane), "+s"(wid));
    const bf16_t* QX = (const bf16_t*)(A.ws + WS_QX); const bf16_t* KVX = (const bf16_t*)(A.ws + WS_KVX); bf16_t* OX = (bf16_t*)(A.ws + WS_OX);
    const int grp = wid >> 2, wsub = wid & 3, r32 = lane & 31, hh = lane >> 5;
    LAS float* wsf = (LAS float*)(lds + WSF_OFF) + wid * 32;
    const int row0 = qb * 256 + grp * 128 + 32 * wsub, myrow = row0 + r32;
    const float* Qp = (const float*)(A.ws + WS_TMP) + (size_t)myrow * 512 + h * 128 + 8 * hh;
    const float qrs = rsqrtf(((const float*)(A.ws + WS_RS))[myrow] * (1.f / 4096.f) + EPS) * QSCALE;
    bf16x8 qf[8];
#pragma unroll
    for (int d0 = 0; d0 < 8; ++d0) { f32x4 a0 = {0.f, 0.f, 0.f, 0.f}, a1 = a0;
#pragma unroll
        for (int ks = 0; ks < 4; ++ks) { a0 += *(const f32x4*)(Qp + (size_t)ks * SEQ * 512 + 16 * d0); a1 += *(const f32x4*)(Qp + (size_t)ks * SEQ * 512 + 16 * d0 + 4); }
        u32x4 w; w.x = pk2(a0[0] * qrs, a0[1] * qrs); w.y = pk2(a0[2] * qrs, a0[3] * qrs); w.z = pk2(a1[0] * qrs, a1[1] * qrs); w.w = pk2(a1[2] * qrs, a1[3] * qrs);
        qf[d0] = __builtin_bit_cast(bf16x8, w); }
    const bf16_t* Kb = KVX + h * 128; const bf16_t* Vb = KVX + 512 + h * 128;
    f32x16 O[4];
#pragma unroll
    for (int c = 0; c < 4; ++c)
#pragma unroll
        for (int r = 0; r < 16; ++r) O[c][r] = 0.f;
    float m_ref = 0.f, l_part = 0.f;
    __syncthreads();
    attn_dma<4>(lds, wid, lane, Kb, Kb, 1024, Vb, 1024);
    int s = 0;
    for (int j = 0; j < 4; ++j) {
        asm volatile("s_waitcnt vmcnt(0)" ::: "memory"); __syncthreads();
        if (j + 1 < 4) attn_dma<4>(lds + (s ^ 1) * STAGE, wid, lane, Kb + (size_t)(j + 1) * 64 * 1024, Kb + (size_t)(j + 1) * 64 * 1024, 1024, Vb + (size_t)(j + 1) * 64 * 1024, 1024);
        const LAS unsigned char* st = lds + s * STAGE;
        attn_tile<4, 4, false>(false, st + grp * 16384, st + 32768, qf, O, m_ref, l_part, wsf, lane, (const LAS int*)(lds + POSK_OFF), 0, (const LAS float*)(lds + LUT_OFF), 0);
        s ^= 1;
    }
    const float lt = l_part + __shfl_xor(l_part, 32);
    scale_rows<4>(O, pg8::rcp_(lt), wsf, lane);
#pragma unroll
    for (int c = 0; c < 4; ++c)
#pragma unroll
        for (int r = 0; r < 16; ++r) OX[(size_t)(row0 + crow(r, hh)) * 512 + h * 128 + 32 * c + r32] = (bf16_t)(pk2(O[c][r], 0.f) & 0xffffu);
    __syncthreads();
}

__device__ __forceinline__ void mixb_unit(LAS unsigned char* lds, const Args& A, int n, int gq, int tid, int wid, int lane) {
    asm volatile("" : "+v"(tid), "+v"(lane), "+s"(wid));
    const bf16_t* PROJ = (const bf16_t*)(A.ws + WS_PROJ); bf16_t* AB = (bf16_t*)(A.ws + WS_AB);
    LAS float* stats = (LAS float*)(lds + 98304);
    const int r32 = lane & 31, hh = lane >> 5;
    __syncthreads();
    for (int rr = 0; rr < 16; ++rr) {
        const int trow = 16 * wid + rr; const bf16_t* src = PROJ + (size_t)(128 * n + trow) * INW + C_VB;
        u32x4 v[8]; float s = 0.f;
#pragma unroll
        for (int j = 0; j < 8; ++j) { v[j] = *(const u32x4*)(src + (lane + 64 * j) * 8);
            s += (bf2f(v[j].x & 0xffffu) + bf2f(v[j].x >> 16)) + (bf2f(v[j].y & 0xffffu) + bf2f(v[j].y >> 16)) + (bf2f(v[j].z & 0xffffu) + bf2f(v[j].z >> 16)) + (bf2f(v[j].w & 0xffffu) + bf2f(v[j].w >> 16)); }
        const float mean = wave_sum(s) * (1.f / 4096.f); float q = 0.f;
#pragma unroll
        for (int j = 0; j < 8; ++j) {
#pragma unroll
            for (int e = 0; e < 4; ++e) { const unsigned w = v[j][e]; const float a = bf2f(w & 0xffffu) - mean, b = bf2f(w >> 16) - mean; q += a * a + b * b; } }
        const float rstd = rsqrtf(wave_sum(q) * (1.f / 4096.f) + EPS);
        if (lane == 0) { stats[2 * trow] = mean; stats[2 * trow + 1] = rstd; }
    }
    __syncthreads();
    for (int gi = 0; gi < 4; ++gi) {
        const int g = gq * 4 + gi;
#pragma unroll
        for (int i = 0; i < 4; ++i) { const int id = tid + 512 * i, t = id >> 4, lc = id & 15; const float* wp = A.sg_w + ((size_t)g * 128 + t) * 128 + lc * 8;
            f32x4 w0 = *(const f32x4*)wp, w1 = *(const f32x4*)(wp + 4);
#pragma unroll
            for (int e = 0; e < 4; ++e) { if (lc * 8 + e > t) w0[e] = 0.f; if (lc * 8 + 4 + e > t) w1[e] = 0.f; }
            u32x4 o; o.x = pk2(w0[0], w0[1]); o.y = pk2(w0[2], w0[3]); o.z = pk2(w1[0], w1[1]); o.w = pk2(w1[2], w1[3]);
            *(LAS u32x4*)(lds + t * 256 + ((lc ^ (t & 15)) << 4)) = o; }
#pragma unroll 2
        for (int i = 0; i < 8; ++i) { const int id = tid + 512 * i, s = id >> 5, lc = id & 31, ch = g * 256 + lc * 8;
            const u32x4 xv = *(const u32x4*)(PROJ + (size_t)(128 * n + s) * INW + C_VB + ch);
            const float mean = stats[2 * s], rstd = stats[2 * s + 1];
            const f32x4 g0 = *(const f32x4*)(A.sg_ln_g + ch), g1 = *(const f32x4*)(A.sg_ln_g + ch + 4), b0 = *(const f32x4*)(A.sg_ln_b + ch), b1 = *(const f32x4*)(A.sg_ln_b + ch + 4);
            u32x4 o;
            o.x = pk2((bf2f(xv.x & 0xffffu) - mean) * rstd * g0[0] + b0[0], (bf2f(xv.x >> 16) - mean) * rstd * g0[1] + b0[1]);
            o.y = pk2((bf2f(xv.y & 0xffffu) - mean) * rstd * g0[2] + b0[2], (bf2f(xv.y >> 16) - mean) * rstd * g0[3] + b0[3]);
            o.z = pk2((bf2f(xv.z & 0xffffu) - mean) * rstd * g1[0] + b1[0], (bf2f(xv.z >> 16) - mean) * rstd * g1[1] + b1[1]);
            o.w = pk2((bf2f(xv.w & 0xffffu) - mean) * rstd * g1[2] + b1[2], (bf2f(xv.w >> 16) - mean) * rstd * g1[3] + b1[3]);
            *(LAS u32x4*)(lds + 32768 + s * 512 + (((lc >> 2) ^ (s & 7)) << 6) + (lc & 3) * 16) = o; }
        __syncthreads();
        const int tb = wid & 3, dh = wid >> 2;
        f32x16 acc[4];
#pragma unroll
        for (int c = 0; c < 4; ++c)
#pragma unroll
            for (int r = 0; r < 16; ++r) acc[c][r] = 0.f;
        const int blk = (lane >> 4) & 1, q = (lane & 15) >> 2, p = lane & 3;
        const LAS unsigned char* ab = lds + (32 * tb + r32) * 256;
        const LAS unsigned char* vb = lds + 32768 + (8 * hh + q) * 512 + blk * 32 + p * 8;
        const int ns0 = 2 * tb + 2;
#pragma unroll 1
        for (int s0 = 0; s0 < ns0; ++s0) {
            const bf16x8 af = *(const LAS bf16x8*)(ab + (((2 * s0 + hh) ^ (r32 & 15)) << 4));
#pragma unroll
            for (int c4 = 0; c4 < 4; ++c4) { const int c = 4 * dh + c4;
                const s16x4 lo = trr(vb + s0 * 16 * 512 + ((c ^ q) << 6)), hi = trr(vb + s0 * 16 * 512 + 4 * 512 + ((c ^ (4 + q)) << 6));
                const bf16x8 vf = {lo[0], lo[1], lo[2], lo[3], hi[0], hi[1], hi[2], hi[3]};
                acc[c4] = __builtin_amdgcn_mfma_f32_32x32x16_bf16(af, vf, acc[c4], 0, 0, 0); }
        }
#pragma unroll
        for (int c4 = 0; c4 < 4; ++c4) { const int ch = g * 256 + 32 * (4 * dh + c4) + r32;
            const bf16_t* ub = PROJ + (size_t)(128 * n + 32 * tb + 4 * hh) * INW + ch; bf16_t* ob = AB + (size_t)(128 * n + 32 * tb + 4 * hh) * DM + ch;
            const float* bb = A.sg_b + g * 128 + 32 * tb + 4 * hh;
            unsigned uu[16], zz[16]; float bs[16];
#pragma unroll
            for (int r = 0; r < 16; ++r) { const int rr = (r & 3) + 8 * (r >> 2); uu[r] = ub[(size_t)rr * INW + C_UB]; zz[r] = ub[(size_t)rr * INW + C_ZB]; bs[r] = bb[rr]; }
#pragma unroll
            for (int r = 0; r < 16; ++r) { const int rr = (r & 3) + 8 * (r >> 2);
                ob[(size_t)rr * DM] = (bf16_t)(pk2(bf2f(uu[r]) * (acc[c4][r] + bs[r]) * bf2f(zz[r]), 0.f) & 0xffffu); }
            __builtin_amdgcn_sched_barrier(0);
        }
        __syncthreads();
    }
}

#define XB_TMO      128
#define XB_XCNT(j)  (256  + 64 * (j))
#define XB_XSUB(j)  (1280 + 64 * (j))
#define XB_XGEN(j)  (2304 + 64 * (j))
#define XB_TOP      3328
#define XB_TOPGEN   3392
#define XCD_BAR_WORDS 3456
#define XB_SPIN_CAP (1u << 18)

__device__ __forceinline__ unsigned xb_ld(unsigned* p)              { return __hip_atomic_load(p, __ATOMIC_RELAXED, __HIP_MEMORY_SCOPE_AGENT); }
__device__ __forceinline__ unsigned xb_add(unsigned* p, unsigned v) { return __hip_atomic_fetch_add(p, v, __ATOMIC_RELAXED, __HIP_MEMORY_SCOPE_AGENT); }
__device__ __forceinline__ unsigned xb_xcc_id() { return (unsigned)__builtin_amdgcn_s_getreg((3 << 11) | 20) & 0xFu; }
#define XB_SPIN(cond, bar) do { unsigned _sp = 0; while (cond) { __builtin_amdgcn_s_sleep(1); \
    if ((++_sp & 255u) == 0u) { if (xb_ld(&(bar)[XB_TMO])) break; if (_sp > XB_SPIN_CAP) { atomicAdd(&(bar)[XB_TMO], 1u); break; } } } } while (0)

struct XcdBarrier {
    unsigned* bar; unsigned x;
    volatile LAS unsigned* st;
};

__device__ __forceinline__ XcdBarrier xcd_barrier_post(unsigned* bar, volatile LAS unsigned* st) {
    XcdBarrier b; b.bar = bar; b.x = xb_xcc_id(); b.st = st;
    if (threadIdx.x == 0) (void)xb_add(&bar[XB_XCNT(b.x)], 1u);
    return b;
}
__device__ __forceinline__ void xcd_barrier_complete(unsigned* bar, unsigned x, unsigned& nloc, unsigned& nx) {
    const unsigned G = gridDim.x * gridDim.y * gridDim.z;
    unsigned sum, cnt, mine, sp = 0u;
    for (;;) {
        sum = 0u; cnt = 0u; mine = 0u;
#pragma unroll
        for (unsigned j = 0; j < 16; ++j) { const unsigned c = xb_ld(&bar[XB_XCNT(j)]); sum += c; cnt += (c > 0u) ? 1u : 0u; mine = (j == x) ? c : mine; }
        if (sum == G) break;
        __builtin_amdgcn_s_sleep(1);
        if ((++sp & 255u) == 0u) { if (xb_ld(&bar[XB_TMO])) break; if (sp > XB_SPIN_CAP) { atomicAdd(&bar[XB_TMO], 1u); break; } }
    }
    nloc = mine > 0u ? mine : 1u; nx = cnt > 0u ? cnt : 1u;
}

__device__ __forceinline__ void xcd_barrier(const XcdBarrier& b) {
    asm volatile("s_waitcnt vmcnt(0)" ::: "memory");
    __syncthreads();
    if (threadIdx.x == 0) {
        unsigned* bar = b.bar;
        __builtin_amdgcn_s_waitcnt(0);
        unsigned nloc = b.st[0], nx = b.st[1];
        if (nloc == 0u) { xcd_barrier_complete(bar, b.x, nloc, nx); b.st[0] = nloc; b.st[1] = nx; }
        const unsigned old = xb_add(&bar[XB_XSUB(b.x)], 1u);
        const unsigned gen = old / nloc;
        if (old + 1u == (gen + 1u) * nloc) {
            __builtin_amdgcn_fence(__ATOMIC_RELEASE, "agent");
            asm volatile("s_waitcnt vmcnt(0)" ::: "memory");
            const unsigned og = xb_add(&bar[XB_TOP], 1u);
            const unsigned tg = og / nx;
            if (og + 1u == (tg + 1u) * nx) xb_add(&bar[XB_TOPGEN], 1u);
            else XB_SPIN(xb_ld(&bar[XB_TOPGEN]) == tg, bar);
            __builtin_amdgcn_fence(__ATOMIC_ACQUIRE, "agent");
            xb_add(&bar[XB_XGEN(b.x)], 1u);
            asm volatile("s_waitcnt vmcnt(0)" ::: "memory");
        } else {
            XB_SPIN(xb_ld(&bar[XB_XGEN(b.x)]) == gen, bar);
            __builtin_amdgcn_fence(__ATOMIC_ACQUIRE, "agent");
            asm volatile("s_waitcnt vmcnt(0)" ::: "memory");
        }
    }
    __syncthreads();
}

#ifndef GEMM_ALIGN
#define GEMM_ALIGN true
#endif
#ifndef GEMM_SP2
#define GEMM_SP2 true
#endif
constexpr bool GA = GEMM_ALIGN, GS = GEMM_SP2;
constexpr int NPH = 9;
__global__ void __launch_bounds__(512) mega_fwd(Args A) {
    extern __shared__ __attribute__((aligned(16))) unsigned char lds_raw[];
    LAS unsigned char* lds = (LAS unsigned char*)lds_raw;
    const int tid = threadIdx.x, lane = tid & 63, wid = __builtin_amdgcn_readfirstlane(tid >> 6);
    const int G = gridDim.x, bx = blockIdx.x;
    const int lo = A.lo, hi = A.hi;
    unsigned char* ws = A.ws;
    if (tid < 4) ((volatile LAS unsigned*)(lds + XBST_OFF))[tid] = 0u;
    __syncthreads();
    const XcdBarrier xbar = xcd_barrier_post((unsigned*)(ws + WS_BAR), (volatile LAS unsigned*)(lds + XBST_OFF));
    bf16_t* PROJ = (bf16_t*)(ws + WS_PROJ);
#ifdef DOUBLE_SYNC
#define DBL_SYNC cooperative_groups::this_grid().sync(); cooperative_groups::this_grid().sync();
#else
#define DBL_SYNC
#endif
#define IN(k) (lo <= (k) && (k) < hi)
#define SEAM(k) do { if (IN(k) && IN((k) + 1)) { if ((k) == 0) { asm volatile("s_waitcnt vmcnt(0)" ::: "memory"); __syncthreads(); cooperative_groups::this_grid().sync(); DBL_SYNC } else xcd_barrier(xbar); } } while (0)

#ifndef REP_P0
#define REP_P0 1
#endif
#ifndef REP_P2
#define REP_P2 1
#endif
    if (IN(0)) for (int rep_ = 0; rep_ < REP_P0; ++rep_) {
        const int gw = bx * 8 + wid, NGW = G * 8;
        for (int i = bx * 512 + tid; i < 8192; i += G * 512) { ((float*)(ws + WS_RS))[i] = 0.f; ((float*)(ws + WS_RS2))[i] = 0.f; }
        if (bx == 0 && tid < 4) ((float*)(ws + WS_TMETA))[512 + tid] = 0.f;
        if (bx == 0 && tid < 128) { int mn = 0x7fffffff, mx = (int)0x80000000; for (int i = 0; i < 64; ++i) { const int v = A.pos[tid * 64 + i]; mn = v < mn ? v : mn; mx = v > mx ? v : mx; }
            ((int*)(ws + WS_TMETA))[tid] = mn; ((int*)(ws + WS_TMETA))[128 + tid] = mx; }
        LAS float* scr = (LAS float*)(lds + wid * 16384);
        constexpr int I_IN = 64 * (INW / 32), I_SQ = 64 * (DM / 32), I_XQ = 64 * (512 / 32), I_XKV = 64 * (1024 / 32), I_XO = 8 * (DM / 32);
        constexpr int NITEMS = I_IN + 3 * I_SQ + I_XQ + I_XKV + I_XO;
        for (int it = gw; it < NITEMS; it += NGW) {
            int r = it;
            if (r < I_IN) { p0_transpose_item(A.w_in, DM, INW, (bf16_t*)(ws + WS_WIN), scr, r, lane); continue; } r -= I_IN;
            if (r < I_SQ) { p0_transpose_item(A.w_pa, DM, DM, (bf16_t*)(ws + WS_WPA), scr, r, lane); continue; } r -= I_SQ;
            if (r < I_SQ) { p0_transpose_item(A.w_pb, DM, DM, (bf16_t*)(ws + WS_WPB), scr, r, lane); continue; } r -= I_SQ;
            if (r < I_SQ) { p0_transpose_item(A.w_out, DM, DM, (bf16_t*)(ws + WS_WOUT), scr, r, lane); continue; } r -= I_SQ;
            if (r < I_XQ) { p0_transpose_item(A.w_xq, DM, 512, (bf16_t*)(ws + WS_WXQ), scr, r, lane); continue; } r -= I_XQ;
            if (r < I_XKV) { p0_transpose_item(A.w_xkv, DM, 1024, (bf16_t*)(ws + WS_WXKV), scr, r, lane); continue; } r -= I_XKV;
            p0_transpose_item(A.w_xo, 512, DM, (bf16_t*)(ws + WS_WXO), scr, r, lane);
        }
        for (int m = gw; m < SEQ + MEML; m += NGW) {
            if (m < SEQ) rms_row_to_bf16(A.x + (size_t)m * DM, A.norm1_g, (bf16_t*)(ws + WS_HN) + (size_t)m * DM, lane);
            else rms_row_to_bf16(A.mem + (size_t)(m - SEQ) * DM, A.norm_mem_g, (bf16_t*)(ws + WS_MN) + (size_t)(m - SEQ) * DM, lane);
        }
        __syncthreads();
    }
    SEAM(0);
    if (IN(1)) {
        { pg8::Gemm g{(const bf16_t*)(ws + WS_HN), (const bf16_t*)(ws + WS_WIN), SEQ, INW, DM}; pg8::StaticOrder S; S.init(SEQ, INW, G, bx);
          pg8::EpiProj E{PROJ, INW, A.b_gate, QSCALE, 0};
          pg8::gemm_phase<pg8::EpiProj, pg8::StaticOrder, GA, GS>(lds, g, S, E); }
        if (bx < 64) { const int v = bx, ks = v >> 2;
            pg8::Gemm g{(const bf16_t*)(ws + WS_MN) + ks * 256, (const bf16_t*)(ws + WS_WXKV) + ks * 256, MEML, 1024, 256, DM}; pg8::StaticOrder S; S.init(MEML, 1024, 4, v & 3);
            pg8::EpiF32<false> E{(float*)(ws + WS_KVF) + (size_t)ks * MEML * 1024, 1024};
            pg8::gemm_phase<pg8::EpiF32<false>, pg8::StaticOrder, GA, GS>(lds, g, S, E); }
    }
    SEAM(1);
    if (IN(2)) for (int rep_ = 0; rep_ < REP_P2; ++rep_) {
        if (tid < 256) ((LAS int*)(lds + TM_OFF))[tid] = ((const int*)(ws + WS_TMETA))[tid];
        __syncthreads();
        float lam;
        { const float a = A.lq1[lane] * A.lk1[lane] + A.lq1[lane + 64] * A.lk1[lane + 64], b = A.lq2[lane] * A.lk2[lane] + A.lq2[lane + 64] * A.lk2[lane + 64];
          lam = expf(wave_sum(a)) - expf(wave_sum(b)) + 0.2f; }
        const int vcu = (G % 8 == 0) ? (bx % 8) * (G / 8) + bx / 8 : bx;
        for (int v = vcu; v < 256; v += G) {
            const int h = v >> 4, sx = v & 15;
#pragma unroll 1
            for (int i = 0; i < 8; ++i) { const int b16 = 16 * (i >> 1), qb = (i & 1) ? b16 + sx : 127 - b16 - sx;
#ifndef SKIP_DIFF
                diff_attn_unit(lds, A, h, qb, lam, tid, wid, lane);
#endif
            }
#ifndef SKIP_MIXB
            mixb_unit(lds, A, v >> 2, v & 3, tid, wid, lane);
#endif
        }
    }
#ifdef FILL_AB
    if (IN(2)) { const u32x4* src = (const u32x4*)(ws + WS_HN); u32x4* dst = (u32x4*)(ws + WS_AB);
        for (size_t i = (size_t)bx * 512 + tid; i < (size_t)SEQ * DM / 8; i += (size_t)G * 512) dst[i] = src[i]; }
#endif
    SEAM(2);
    if (IN(3)) {
        { pg8::Gemm g{(const bf16_t*)(ws + WS_AA), (const bf16_t*)(ws + WS_WPA), SEQ, DM, DM}; pg8::StaticOrder S; S.init(SEQ, DM, G, bx);
          pg8::EpiGateA E{PROJ + C_G, INW, (float*)(ws + WS_TMP), DM, A.b_gate};
          pg8::gemm_phase<pg8::EpiGateA, pg8::StaticOrder, GA, GS>(lds, g, S, E); }
#ifdef SYNC_P3
        cooperative_groups::this_grid().sync();
#endif
        { pg8::Gemm g{(const bf16_t*)(ws + WS_AB), (const bf16_t*)(ws + WS_WPB), SEQ, DM, DM}; pg8::StaticOrder S; S.init(SEQ, DM, G, bx);
          pg8::EpiGateB E{PROJ + C_G + DM, INW, (const float*)(ws + WS_TMP), DM, (bf16_t*)(ws + WS_MRG), DM, A.b_gate + DM};
          pg8::gemm_phase<pg8::EpiGateB, pg8::StaticOrder, GA, GS>(lds, g, S, E); }
    }
    SEAM(3);
    if (IN(4)) {
        pg8::Gemm g{(const bf16_t*)(ws + WS_MRG), (const bf16_t*)(ws + WS_WOUT), SEQ, DM, DM}; pg8::StaticOrder S; S.init(SEQ, DM, G, bx);
        pg8::EpiRes E{A.x, (float*)(ws + WS_H1), DM, A.norm_x_g, (bf16_t*)(ws + WS_HG), (float*)(ws + WS_RS)};
        pg8::gemm_phase<pg8::EpiRes, pg8::StaticOrder, GA, GS>(lds, g, S, E);
    }
    SEAM(4);
    if (IN(5)) {
        for (int i = bx * 512 + tid; i < MEML * 1024 / 2; i += G * 512) { float a = 0.f, b = 0.f;
#pragma unroll
            for (int ks = 0; ks < 16; ++ks) { a += ((const float*)(ws + WS_KVF))[(size_t)ks * MEML * 1024 + 2 * i]; b += ((const float*)(ws + WS_KVF))[(size_t)ks * MEML * 1024 + 2 * i + 1]; }
            ((unsigned*)(ws + WS_KVX))[i] = pk2(a, b); }
        if (bx < 256) { const int v = bx, ks = v >> 6;
            pg8::Gemm g{(const bf16_t*)(ws + WS_HG) + ks * 1024, (const bf16_t*)(ws + WS_WXQ) + ks * 1024, SEQ, 512, 1024, DM}; pg8::StaticOrder S; S.init(SEQ, 512, 64, v & 63);
            pg8::EpiF32<false> E{(float*)(ws + WS_TMP) + (size_t)ks * SEQ * 512, 512};
            pg8::gemm_phase<pg8::EpiF32<false>, pg8::StaticOrder, GA, GS>(lds, g, S, E); }
    }
    SEAM(5);
    if (IN(6)) {
#ifndef SKIP_CROSS
        for (int v = bx; v < 128; v += G) cross_attn_unit(lds, A, v & 3, v >> 2, tid, wid, lane);
#endif
    }
    SEAM(6);
    if (IN(7)) {
        pg8::Gemm g{(const bf16_t*)(ws + WS_OX), (const bf16_t*)(ws + WS_WXO), SEQ, DM, 512}; pg8::StaticOrder S; S.init(SEQ, DM, G, bx);
        pg8::EpiRes E{(const float*)(ws + WS_H1), A.out, DM, A.final_g, nullptr, (float*)(ws + WS_RS2)};
        pg8::gemm_phase<pg8::EpiRes, pg8::StaticOrder, GA, GS>(lds, g, S, E);
    }
    SEAM(7);
#ifdef DBG_STAT
    if (IN(8)) {
        const bf16_t* base = PROJ; int cols = 4096, pitch = INW; const float* fa = nullptr; const float* fb = nullptr;
        if (DBG_STAT == 1) { base = PROJ + C_ZA; }
        else if (DBG_STAT == 2) { base = (const bf16_t*)(ws + WS_AA); pitch = DM; }
        else if (DBG_STAT == 3) { base = (const bf16_t*)(ws + WS_AB); pitch = DM; }
        else if (DBG_STAT == 4) { base = PROJ + C_Q; }
        else if (DBG_STAT == 5) { base = PROJ + C_G; cols = 8192; }
        else if (DBG_STAT == 6) { base = PROJ + C_UB; }
        else if (DBG_STAT == 7) { base = PROJ + C_V; }
        else if (DBG_STAT == 8) { base = PROJ + C_VB; }
        else if (DBG_STAT == 9) { base = PROJ + C_K; }
        else if (DBG_STAT == 10) { base = (const bf16_t*)(ws + WS_MRG); pitch = DM; }
        else if (DBG_STAT == 11) { base = (const bf16_t*)(ws + WS_HG); pitch = DM; }
        else if (DBG_STAT == 12) { base = (const bf16_t*)(ws + WS_QX); cols = 512; pitch = 512; }
        else if (DBG_STAT == 14) { base = (const bf16_t*)(ws + WS_OX); cols = 512; pitch = 512; }
        else if (DBG_STAT == 15) { fa = A.out; fb = (const float*)(ws + WS_H1); }
        else if (DBG_STAT == 16) { fa = (const float*)(ws + WS_H1); fb = A.x; }
        float acc = 0.f;
        if (DBG_STAT == 30 || DBG_STAT == 31) {
            const int sid = bx * 8 + wid; const unsigned hsh = (unsigned)(sid + 1) * 2654435761u;
            float num = 0.f, den = 0.f;
            if (DBG_STAT == 30) {
                const int r = (int)((hsh >> 7) % (unsigned)SEQ), h = (int)((hsh >> 3) & 15u);
                float lam_; { const float a = A.lq1[lane] * A.lk1[lane] + A.lq1[lane + 64] * A.lk1[lane + 64], b = A.lq2[lane] * A.lk2[lane] + A.lq2[lane + 64] * A.lk2[lane + 64];
                    lam_ = expf(wave_sum(a)) - expf(wave_sum(b)) + 0.2f; }
                const bf16_t* qp = PROJ + (size_t)r * INW + C_Q + h * 256;
                const float q10 = bf2f(qp[2 * lane]), q11 = bf2f(qp[2 * lane + 1]), q20 = bf2f(qp[128 + 2 * lane]), q21 = bf2f(qp[128 + 2 * lane + 1]);
                float m1 = -1e30f, m2 = -1e30f, l1 = 0.f, l2 = 0.f, a1[4] = {0.f, 0.f, 0.f, 0.f}, a2[4] = {0.f, 0.f, 0.f, 0.f};
                const int pr = A.pos[r];
                for (int j = 0; j < SEQ; ++j) {
                    const int rel = pr - A.pos[j]; if (rel < 0) continue;
                    const bf16_t* kp = PROJ + (size_t)j * INW + C_K + h * 256; const bf16_t* vp = PROJ + (size_t)j * INW + C_V + h * 256 + 4 * lane;
                    float s1 = wave_sum(q10 * bf2f(kp[2 * lane]) + q11 * bf2f(kp[2 * lane + 1])), s2 = wave_sum(q20 * bf2f(kp[128 + 2 * lane]) + q21 * bf2f(kp[128 + 2 * lane + 1]));
                    int bkt; if (rel < 16) bkt = rel; else { const float nf = (float)rel; bkt = 16 + (int)(logf(nf / 16.f) / 2.0794415416798357f * 16.f); bkt = bkt > 31 ? 31 : bkt; }
                    const float bias = A.rel_bias[bkt * 16 + h] * LOG2E; s1 += bias; s2 += bias;
                    const float v0 = bf2f(vp[0]), v1 = bf2f(vp[1]), v2 = bf2f(vp[2]), v3 = bf2f(vp[3]);
                    { const float mn = fmaxf(m1, s1), al = exp2f(m1 - mn), p = exp2f(s1 - mn); l1 = l1 * al + p; a1[0] = a1[0] * al + p * v0; a1[1] = a1[1] * al + p * v1; a1[2] = a1[2] * al + p * v2; a1[3] = a1[3] * al + p * v3; m1 = mn; }
                    { const float mn = fmaxf(m2, s2), al = exp2f(m2 - mn), p = exp2f(s2 - mn); l2 = l2 * al + p; a2[0] = a2[0] * al + p * v0; a2[1] = a2[1] * al + p * v1; a2[2] = a2[2] * al + p * v2; a2[3] = a2[3] * al + p * v3; m2 = mn; }
                }
                float o[4], ssq = 0.f;
                for (int e = 0; e < 4; ++e) { o[e] = a1[e] / l1 - lam_ * a2[e] / l2; ssq += o[e] * o[e]; }
                const float rstd = rsqrtf(wave_sum(ssq) * (1.f / 256.f) + EPS) * 0.8f;
                for (int e = 0; e < 4; ++e) { const int d = 4 * lane + e; const float ex = o[e] * rstd * A.subln_g[d] * bf2f(PROJ[(size_t)r * INW + C_ZA + h * 256 + d]);
                    const float st = bf2f(((const bf16_t*)(ws + WS_AA))[(size_t)r * DM + h * 256 + d]); num += fabsf(ex - st); den += fabsf(ex); }
            } else {
                const int tok = (int)((hsh >> 7) % (unsigned)SEQ), g = (int)((hsh >> 3) & 15u), n = tok >> 7, t = tok & 127;
                float mx[4] = {0.f, 0.f, 0.f, 0.f};
                for (int s_ = 0; s_ <= t; ++s_) { const bf16_t* rowp = PROJ + (size_t)(128 * n + s_) * INW + C_VB; float sm = 0.f, sq = 0.f;
                    for (int e = 0; e < 64; ++e) { const float v = bf2f(rowp[lane + 64 * e]); sm += v; sq += v * v; }
                    const float mean = wave_sum(sm) * (1.f / 4096.f), var = wave_sum(sq) * (1.f / 4096.f) - mean * mean, rstd = rsqrtf(var + EPS);
                    const float w = A.sg_w[((size_t)g * 128 + t) * 128 + s_];
                    for (int e = 0; e < 4; ++e) { const int ch = g * 256 + 4 * lane + e; mx[e] += w * ((bf2f(rowp[ch]) - mean) * rstd * A.sg_ln_g[ch] + A.sg_ln_b[ch]); } }
                for (int e = 0; e < 4; ++e) { const int ch = g * 256 + 4 * lane + e; const float ex = bf2f(PROJ[(size_t)tok * INW + C_UB + ch]) * (mx[e] + A.sg_b[g * 128 + t]) * bf2f(PROJ[(size_t)tok * INW + C_ZB + ch]);
                    const float st = bf2f(((const bf16_t*)(ws + WS_AB))[(size_t)tok * DM + ch]); num += fabsf(ex - st); den += fabsf(ex); }
            }
            num = wave_sum(num); den = wave_sum(den);
            if (lane == 0) { atomicAdd((float*)(ws + WS_TMETA) + 513, num); atomicAdd((float*)(ws + WS_TMETA) + 514, den); }
            asm volatile("s_waitcnt vmcnt(0)" ::: "memory"); __syncthreads(); cooperative_groups::this_grid().sync();
            if (bx == 0 && tid == 0) { const float n_ = __hip_atomic_load((float*)(ws + WS_TMETA) + 513, __ATOMIC_RELAXED, __HIP_MEMORY_SCOPE_AGENT), d_ = __hip_atomic_load((float*)(ws + WS_TMETA) + 514, __ATOMIC_RELAXED, __HIP_MEMORY_SCOPE_AGENT);
                atomicAdd((float*)(ws + WS_TMETA) + 512, n_ / d_); }
        } else
        if ((DBG_STAT >= 20 && DBG_STAT < 30) || (DBG_STAT >= 33 && DBG_STAT <= 35)) {
            const int sid = bx * 512 + tid; const unsigned hsh = (unsigned)(sid + 1) * 2654435761u;
            int r = (int)((hsh >> 8) % (unsigned)SEQ); float dot = 0.f, st = 0.f;
            if (DBG_STAT <= 24) {
                const int csec = (DBG_STAT == 20) ? C_V : (DBG_STAT == 21) ? C_K : (DBG_STAT == 22) ? C_Q : (DBG_STAT == 23) ? C_UB : C_G;
                const int c = csec + (int)((hsh >> 3) % (DBG_STAT == 24 ? 8192u : 4096u));
                const bf16_t* hn = (const bf16_t*)(ws + WS_HN) + (size_t)r * DM;
                for (int k = 0; k < DM; ++k) dot += bf2f(hn[k]) * A.w_in[(size_t)k * INW + c];
                if (DBG_STAT == 22) dot *= QSCALE;
                if (DBG_STAT == 23) dot = pg8::gelut_(dot);
                st = bf2f(PROJ[(size_t)r * INW + c]);
            } else if (DBG_STAT == 25) {
                const int c = (int)((hsh >> 3) % 4096u); const bf16_t* aa = (const bf16_t*)(ws + WS_AA) + (size_t)r * DM; const bf16_t* ab = (const bf16_t*)(ws + WS_AB) + (size_t)r * DM;
                float ya = 0.f, yb = 0.f;
                for (int k = 0; k < DM; ++k) { ya += bf2f(aa[k]) * A.w_pa[(size_t)k * DM + c]; yb += bf2f(ab[k]) * A.w_pb[(size_t)k * DM + c]; }
                dot = ya / (1.f + expf(-(bf2f(PROJ[(size_t)r * INW + C_G + c]) + A.b_gate[c]))) + yb / (1.f + expf(-(bf2f(PROJ[(size_t)r * INW + C_G + DM + c]) + A.b_gate[DM + c])));
                st = bf2f(((const bf16_t*)(ws + WS_MRG))[(size_t)r * DM + c]);
            } else if (DBG_STAT == 26) {
                const int c = (int)((hsh >> 3) % 4096u); const bf16_t* mg = (const bf16_t*)(ws + WS_MRG) + (size_t)r * DM;
                for (int k = 0; k < DM; ++k) dot += bf2f(mg[k]) * A.w_out[(size_t)k * DM + c];
                st = ((const float*)(ws + WS_H1))[(size_t)r * DM + c] - A.x[(size_t)r * DM + c];
            } else if (DBG_STAT == 27) {
                const int c = (int)((hsh >> 3) % 512u); const float* h1 = (const float*)(ws + WS_H1) + (size_t)r * DM; float ssq = 0.f;
                for (int k = 0; k < DM; ++k) { ssq += h1[k] * h1[k]; dot += h1[k] * A.norm_x_g[k] * A.w_xq[(size_t)k * 512 + c]; }
                dot *= rsqrtf(ssq * (1.f / 4096.f) + EPS) * QSCALE;
                st = bf2f(((const bf16_t*)(ws + WS_QX))[(size_t)r * 512 + c]);
            } else if (DBG_STAT == 28) {
                const int c = (int)((hsh >> 3) % 512u), h = c >> 7; const bf16_t* qx = (const bf16_t*)(ws + WS_QX) + (size_t)r * 512 + h * 128; const bf16_t* kv = (const bf16_t*)(ws + WS_KVX);
                float m = -1e30f, l = 0.f, ac = 0.f;
                for (int j = 0; j < MEML; ++j) { float sc = 0.f; for (int k = 0; k < 128; ++k) sc += bf2f(qx[k]) * bf2f(kv[(size_t)j * 1024 + h * 128 + k]);
                    const float mn = fmaxf(m, sc), al = exp2f(m - mn), p = exp2f(sc - mn); l = l * al + p; ac = ac * al + p * bf2f(kv[(size_t)j * 1024 + 512 + c]); m = mn; }
                dot = ac / l; st = bf2f(((const bf16_t*)(ws + WS_OX))[(size_t)r * 512 + c]);
            } else if (DBG_STAT == 29) {
                const int c = (int)((hsh >> 3) % 4096u); const bf16_t* ox = (const bf16_t*)(ws + WS_OX) + (size_t)r * 512;
                for (int k = 0; k < 512; ++k) dot += bf2f(ox[k]) * A.w_xo[(size_t)k * DM + c];
                dot += ((const float*)(ws + WS_H1))[(size_t)r * DM + c]; st = A.out[(size_t)r * DM + c];
            } else if (DBG_STAT == 34 || DBG_STAT == 35) {
                const float* hp = (DBG_STAT == 34) ? A.out + (size_t)r * DM : (const float*)(ws + WS_H1) + (size_t)r * DM;
                for (int k = 0; k < DM; ++k) dot += hp[k] * hp[k];
                st = ((const float*)(ws + (DBG_STAT == 34 ? WS_RS2 : WS_RS)))[r];
#ifdef DBG_HALF
                st *= 0.5f;
#endif
            } else {
                r = r % MEML; const int c = (int)((hsh >> 3) % 1024u); const bf16_t* mn_ = (const bf16_t*)(ws + WS_MN) + (size_t)r * DM;
                for (int k = 0; k < DM; ++k) dot += bf2f(mn_[k]) * A.w_xkv[(size_t)k * 1024 + c];
                st = bf2f(((const bf16_t*)(ws + WS_KVX))[(size_t)r * 1024 + c]);
            }
            float num = wave_sum(fabsf(dot - st)), den = wave_sum(fabsf(dot));
            if (lane == 0) { atomicAdd((float*)(ws + WS_TMETA) + 513, num); atomicAdd((float*)(ws + WS_TMETA) + 514, den); }
            asm volatile("s_waitcnt vmcnt(0)" ::: "memory"); __syncthreads(); cooperative_groups::this_grid().sync();
            if (bx == 0 && tid == 0) { const float n_ = __hip_atomic_load((float*)(ws + WS_TMETA) + 513, __ATOMIC_RELAXED, __HIP_MEMORY_SCOPE_AGENT), d_ = __hip_atomic_load((float*)(ws + WS_TMETA) + 514, __ATOMIC_RELAXED, __HIP_MEMORY_SCOPE_AGENT);
                atomicAdd((float*)(ws + WS_TMETA) + 512, n_ / d_); }
        } else
        if (fa) { for (int r = bx; r < SEQ; r += G) for (int c = tid; c < DM; c += 512) acc += fabsf(fa[(size_t)r * DM + c] - fb[(size_t)r * DM + c]); cols = DM; }
        else { for (int r = bx; r < SEQ; r += G) for (int c = tid; c < cols; c += 512) acc += fabsf(bf2f(base[(size_t)r * pitch + c])); }
        acc = wave_sum(acc);
        if (lane == 0) atomicAdd((float*)(ws + WS_TMETA) + 512, acc / ((float)SEQ * (float)cols));
        asm volatile("s_waitcnt vmcnt(0)" ::: "memory"); __syncthreads(); cooperative_groups::this_grid().sync();
        const int gw = bx * 8 + wid, NGW = G * 8; const float sv = ((const float*)(ws + WS_TMETA))[512];
        const float cc = 1.f + 2.f * fminf(fmaxf(sv, 0.f), 1.f);
        for (int m = gw; m < SEQ; m += NGW) {
            const f32x4* xr = (const f32x4*)(A.x + (size_t)m * DM) + lane; f32x4* o = (f32x4*)(A.out + (size_t)m * DM) + lane; const f32x4* gr = (const f32x4*)A.final_g + lane;
            float ssq = 0.f;
            for (int j = 0; j < 16; ++j) { const f32x4 v = xr[64 * j]; ssq += v.x * v.x + v.y * v.y + v.z * v.z + v.w * v.w; }
            const float rs = rsqrtf(wave_sum(ssq) * (1.f / 4096.f) + EPS) * cc;
            for (int j = 0; j < 16; ++j) { o[64 * j] = xr[64 * j] * rs * gr[64 * j]; }
        }
    }
    return;
#endif
    if (IN(8)) {
        const int gw = bx * 8 + wid, NGW = G * 8; const float* RS2 = (const float*)(ws + WS_RS2);
        for (int m = gw; m < SEQ; m += NGW) { const float rs = rsqrtf(RS2[m] * (1.f / 4096.f) + EPS);
            f32x4* o = (f32x4*)(A.out + (size_t)m * DM) + lane; const f32x4* gr = (const f32x4*)A.final_g + lane;
#pragma unroll 4
            for (int j = 0; j < 16; ++j) { f32x4 v = o[64 * j]; const f32x4 gg = gr[64 * j]; v = v * rs * gg; o[64 * j] = v; } }
    }
#undef IN
#undef SEAM
}

#ifndef MK_MULTI
#define MK_MULTI 0
#endif
extern "C" void kernel_launch(void* const* d_in, const int* in_sizes, int n_in, void* d_out, int out_size, void* d_ws, size_t ws_size, hipStream_t stream) {
    static int grid = 0;
    if (grid == 0) {
        if (n_in != 25 || ws_size < WS_END) { fprintf(stderr, "kernel_launch: unexpected n_in %d / ws %zu (need %zu)\n", n_in, ws_size, (size_t)WS_END); grid = -1; return; }
        int dev = 0, cus = 0, per_cu = 0;
        hipGetDevice(&dev); hipDeviceGetAttribute(&cus, hipDeviceAttributeMultiprocessorCount, dev);
        if (hipFuncSetAttribute((const void*)mega_fwd, hipFuncAttributeMaxDynamicSharedMemorySize, LDS_BYTES) != hipSuccess) { fprintf(stderr, "kernel_launch: hipFuncSetAttribute failed\n"); grid = -1; return; }
        hipOccupancyMaxActiveBlocksPerMultiprocessor(&per_cu, (const void*)mega_fwd, 512, LDS_BYTES);
        if (per_cu < 1) per_cu = 1;
        (void)hipGetLastError();
        grid = cus * 1;
        if (grid < 256) { fprintf(stderr, "kernel_launch: this kernel needs >= 256 CUs (got %d)\n", grid); grid = -1; return; }
    }
    if (grid < 0) return;
    Args a{};
    a.x = (const float*)d_in[0]; a.pos = (const int*)d_in[1]; a.mem = (const float*)d_in[2]; a.w_in = (const float*)d_in[3]; a.b_gate = (const float*)d_in[4];
    a.norm1_g = (const float*)d_in[5]; a.lq1 = (const float*)d_in[6]; a.lk1 = (const float*)d_in[7]; a.lq2 = (const float*)d_in[8]; a.lk2 = (const float*)d_in[9];
    a.subln_g = (const float*)d_in[10]; a.rel_bias = (const float*)d_in[11]; a.sg_ln_g = (const float*)d_in[12]; a.sg_ln_b = (const float*)d_in[13];
    a.sg_w = (const float*)d_in[14]; a.sg_b = (const float*)d_in[15]; a.w_pa = (const float*)d_in[16]; a.w_pb = (const float*)d_in[17]; a.w_out = (const float*)d_in[18];
    a.norm_x_g = (const float*)d_in[19]; a.norm_mem_g = (const float*)d_in[20]; a.w_xq = (const float*)d_in[21]; a.w_xkv = (const float*)d_in[22]; a.w_xo = (const float*)d_in[23];
    a.final_g = (const float*)d_in[24];
    a.out = (float*)d_out; a.ws = (unsigned char*)d_ws;
#if MK_MULTI
    for (int ph = 0; ph < NPH; ++ph) { a.lo = ph; a.hi = ph + 1; hipLaunchKernelGGL(mega_fwd, dim3(grid), dim3(512), LDS_BYTES, stream, a); }
#else
    a.lo = 0; a.hi = NPH;
    (void)hipMemsetAsync((char*)d_ws + WS_BAR, 0, BAR_BYTES, stream);
    void* args[] = {&a};
    hipError_t e = hipLaunchCooperativeKernel((const void*)mega_fwd, dim3(grid), dim3(512), args, LDS_BYTES, stream);
    if (e != hipSuccess) fprintf(stderr, "cooperative launch failed: %s (grid %d)\n", hipGetErrorString(e), grid);
#endif
}
```

```cpp
#include <hip/hip_runtime.h>
#include <hip/hip_cooperative_groups.h>
#include <cstdio>
#include <cstdint>
#include <cmath>
namespace pg8 {
#define PG8_LAS __attribute__((address_space(3)))
typedef unsigned short bf16_t;
typedef short bf16x8 __attribute__((ext_vector_type(8)));
typedef float f32x4 __attribute__((ext_vector_type(4)));
typedef unsigned u32x4 __attribute__((ext_vector_type(4)));
constexpr int BM = 256, BK = 64, HALF = 128, HTB = HALF * BK * 2  , STAGE_BYTES = 8 * HTB, NXCD = 8, WGM = 8;

__host__ __device__ __forceinline__ int lds_byte(int r, int c) { const int st = (r >> 4) * 2 + (c >> 5), rr = r & 15, cc = c & 31, ob = rr * 64 + cc * 2; return st * 1024 + (ob ^ (((ob >> 9) & 1) << 5)); }
__host__ __device__ __forceinline__ void stage_rc(int b, int& R, int& C) { const int st = b / 1024, sb = b % 1024, swz = sb ^ (((sb >> 9) & 1) << 5); R = (st >> 1) * 16 + swz / 64; C = (st & 1) * 32 + (swz % 64) / 2; }
__host__ __device__ __forceinline__ int perm32(int rho) { const int n = rho >> 4, i = rho & 15; return 8 * (i >> 2) + 4 * n + (i & 3); }

struct Unit { int pm, pn; };
struct Gemm { const bf16_t* A; const bf16_t* Bt; int M, N, K; int ld; };

struct StaticOrder {
    int nM, nN, nwg, G, c;
    __host__ __device__ void init(int M, int N, int G_, int c_) { nM = M / BM; nN = N / BM; nwg = nM * nN; G = G_; c = c_; }
    __host__ __device__ bool next(int i, Unit& u) const {
        const long L = (long)i * G + c; if (L >= nwg) return false;
        int wgid = (int)L; { const int q = nwg / NXCD, r = nwg % NXCD, xcd = wgid % NXCD, off = wgid / NXCD; wgid = (xcd < r ? xcd * (q + 1) : r * (q + 1) + (xcd - r) * q) + off; }
        const int nig = WGM * nN, gid = wgid / nig, fm = gid * WGM, gsz = (nM - fm) < WGM ? (nM - fm) : WGM;
        u.pm = fm + ((wgid % nig) % gsz); u.pn = (wgid % nig) / gsz; return true;
    }
    __device__ __forceinline__ void a_ready(const Unit&) const {}
    __device__ __forceinline__ void done(const Unit&) const {}
};

__device__ __forceinline__ unsigned cvt_pk_bf16(float lo, float hi) { unsigned r; asm volatile("v_cvt_pk_bf16_f32 %0, %1, %2" : "=v"(r) : "v"(lo), "v"(hi)); return r; }
typedef float f32x2 __attribute__((ext_vector_type(2)));
__device__ __forceinline__ float ex2_(float x) { return __builtin_amdgcn_exp2f(x); }
__device__ __forceinline__ float rcp_(float x) { return __builtin_amdgcn_rcpf(x); }
__device__ __forceinline__ float sigm_(float x) { return rcp_(1.f + ex2_(-1.4426950408889634f * x)); }
__device__ __forceinline__ float silu_(float x) { return x * sigm_(x); }
__device__ __forceinline__ float gelut_(float x) { const float u = 0.7978845608028654f * (x + 0.044715f * x * x * x); return x * sigm_(2.f * u); }
__device__ __forceinline__ float bf2f_(unsigned b) { return __uint_as_float(b << 16); }
template <int MODE> __device__ __forceinline__ float act_(float v, float sc) {
    if (MODE == 1) return v * sc; if (MODE == 2) return silu_(v); if (MODE == 3) return gelut_(v); if (MODE == 4) return sigm_(v); return v; }

struct EpiProj {
    static constexpr bool PERM = true, AFTER_DRAIN = false;
    bf16_t* O; int ldc; const float* bgate; float qscale; int plain;
    template <int MODE> __device__ __forceinline__ void run(const f32x4 (&acc)[2][2][4][2], const Unit& u, int wr, int wc, int fr, int fq) const {
        const int row0 = u.pm * BM + wr * 64 + fr, col0 = u.pn * BM + wc * 32 + 8 * fq;
        f32x4 bv[2][2];
#pragma unroll
        for (int bj = 0; bj < 2; ++bj)
#pragma unroll
            for (int n = 0; n < 2; ++n) bv[bj][n] = (MODE == 4) ? *(const f32x4*)(bgate + (col0 - 28672) + bj * HALF + 4 * n) : (f32x4){0.f, 0.f, 0.f, 0.f};
#pragma unroll
        for (int ai = 0; ai < 2; ++ai)
#pragma unroll
            for (int m = 0; m < 4; ++m) { bf16_t* rowp = O + (size_t)(row0 + ai * HALF + m * 16) * ldc + col0;
#pragma unroll
                for (int bj = 0; bj < 2; ++bj) { f32x4 v0 = acc[ai][bj][m][0] + bv[bj][0], v1 = acc[ai][bj][m][1] + bv[bj][1];
#pragma unroll
                    for (int e = 0; e < 4; ++e) { v0[e] = act_<MODE>(v0[e], qscale); v1[e] = act_<MODE>(v1[e], qscale); }
                    u32x4 w; w.x = cvt_pk_bf16(v0[0], v0[1]); w.y = cvt_pk_bf16(v0[2], v0[3]); w.z = cvt_pk_bf16(v1[0], v1[1]); w.w = cvt_pk_bf16(v1[2], v1[3]);
                    *(u32x4*)(rowp + bj * HALF) = w; } }
    }
    __device__ __forceinline__ void operator()(const f32x4 (&acc)[2][2][4][2], const Unit& u, int wr, int wc, int fr, int fq) const {
        const int sect = u.pn >> 4;
        if (plain || sect == 1 || sect == 2 || sect >= 7) run<0>(acc, u, wr, wc, fr, fq);
        else if (sect == 0) run<1>(acc, u, wr, wc, fr, fq);
        else if (sect == 3 || sect == 6) run<2>(acc, u, wr, wc, fr, fq);
        else if (sect == 4 || sect == 5) run<3>(acc, u, wr, wc, fr, fq);
        else run<4>(acc, u, wr, wc, fr, fq);
    }
};
struct EpiGateA {
    static constexpr bool PERM = true, AFTER_DRAIN = false;
    const bf16_t* G; int ldg; float* T; int ldt; const float* bg;
    __device__ __forceinline__ void operator()(const f32x4 (&acc)[2][2][4][2], const Unit& u, int wr, int wc, int fr, int fq) const {
        const int row0 = u.pm * BM + wr * 64 + fr, col0 = u.pn * BM + wc * 32 + 8 * fq;
#pragma unroll
        for (int ai = 0; ai < 2; ++ai)
#pragma unroll
            for (int m = 0; m < 4; ++m) { const size_t row = (size_t)(row0 + ai * HALF + m * 16);
#pragma unroll
                for (int bj = 0; bj < 2; ++bj) { const int col = col0 + bj * HALF; const u32x4 g = *(const u32x4*)(G + row * ldg + col);
                    f32x4 v0 = acc[ai][bj][m][0], v1 = acc[ai][bj][m][1];
                    const f32x4 b0 = *(const f32x4*)(bg + col), b1 = *(const f32x4*)(bg + col + 4);
                    v0[0] *= sigm_(bf2f_(g.x & 0xffffu) + b0[0]); v0[1] *= sigm_(bf2f_(g.x >> 16) + b0[1]); v0[2] *= sigm_(bf2f_(g.y & 0xffffu) + b0[2]); v0[3] *= sigm_(bf2f_(g.y >> 16) + b0[3]);
                    v1[0] *= sigm_(bf2f_(g.z & 0xffffu) + b1[0]); v1[1] *= sigm_(bf2f_(g.z >> 16) + b1[1]); v1[2] *= sigm_(bf2f_(g.w & 0xffffu) + b1[2]); v1[3] *= sigm_(bf2f_(g.w >> 16) + b1[3]);
                    *(f32x4*)(T + row * ldt + col) = v0; *(f32x4*)(T + row * ldt + col + 4) = v1; } }
    }
};
struct EpiGateB {
    static constexpr bool PERM = true, AFTER_DRAIN = false;
    const bf16_t* G; int ldg; const float* T; int ldt; bf16_t* O; int ldc; const float* bg;
    __device__ __forceinline__ void operator()(const f32x4 (&acc)[2][2][4][2], const Unit& u, int wr, int wc, int fr, int fq) const {
        const int row0 = u.pm * BM + wr * 64 + fr, col0 = u.pn * BM + wc * 32 + 8 * fq;
#pragma unroll
        for (int ai = 0; ai < 2; ++ai)
#pragma unroll
            for (int m = 0; m < 4; ++m) { const size_t row = (size_t)(row0 + ai * HALF + m * 16);
#pragma unroll
                for (int bj = 0; bj < 2; ++bj) { const int col = col0 + bj * HALF; const u32x4 g = *(const u32x4*)(G + row * ldg + col);
                    f32x4 v0 = acc[ai][bj][m][0], v1 = acc[ai][bj][m][1];
                    const f32x4 t0 = *(const f32x4*)(T + row * ldt + col), t1 = *(const f32x4*)(T + row * ldt + col + 4);
                    const f32x4 b0 = *(const f32x4*)(bg + col), b1 = *(const f32x4*)(bg + col + 4);
                    v0[0] = t0[0] + v0[0] * sigm_(bf2f_(g.x & 0xffffu) + b0[0]); v0[1] = t0[1] + v0[1] * sigm_(bf2f_(g.x >> 16) + b0[1]); v0[2] = t0[2] + v0[2] * sigm_(bf2f_(g.y & 0xffffu) + b0[2]); v0[3] = t0[3] + v0[3] * sigm_(bf2f_(g.y >> 16) + b0[3]);
                    v1[0] = t1[0] + v1[0] * sigm_(bf2f_(g.z & 0xffffu) + b1[0]); v1[1] = t1[1] + v1[1] * sigm_(bf2f_(g.z >> 16) + b1[1]); v1[2] = t1[2] + v1[2] * sigm_(bf2f_(g.w & 0xffffu) + b1[2]); v1[3] = t1[3] + v1[3] * sigm_(bf2f_(g.w >> 16) + b1[3]);
                    u32x4 w; w.x = cvt_pk_bf16(v0[0], v0[1]); w.y = cvt_pk_bf16(v0[2], v0[3]); w.z = cvt_pk_bf16(v1[0], v1[1]); w.w = cvt_pk_bf16(v1[2], v1[3]);
                    *(u32x4*)(O + row * ldc + col) = w; } }
    }
};
struct EpiRes {
    static constexpr bool PERM = true, AFTER_DRAIN = false;
    const float* X; float* H; int ld; const float* gx; bf16_t* HG; float* RS;
    __device__ __forceinline__ void operator()(const f32x4 (&acc)[2][2][4][2], const Unit& u, int wr, int wc, int fr, int fq) const {
        const int row0 = u.pm * BM + wr * 64 + fr, col0 = u.pn * BM + wc * 32 + 8 * fq;
#pragma unroll
        for (int ai = 0; ai < 2; ++ai)
#pragma unroll
            for (int m = 0; m < 4; ++m) { const size_t row = (size_t)(row0 + ai * HALF + m * 16); float ss = 0.f;
#pragma unroll
                for (int bj = 0; bj < 2; ++bj) { const int col = col0 + bj * HALF;
                    const f32x4 h0 = *(const f32x4*)(X + row * ld + col) + acc[ai][bj][m][0], h1 = *(const f32x4*)(X + row * ld + col + 4) + acc[ai][bj][m][1];
                    *(f32x4*)(H + row * ld + col) = h0; *(f32x4*)(H + row * ld + col + 4) = h1;
                    ss += (h0[0] * h0[0] + h0[1] * h0[1]) + (h0[2] * h0[2] + h0[3] * h0[3]) + (h1[0] * h1[0] + h1[1] * h1[1]) + (h1[2] * h1[2] + h1[3] * h1[3]);
                    if (HG) { const f32x4 g0 = *(const f32x4*)(gx + col), g1 = *(const f32x4*)(gx + col + 4);
                        u32x4 w; w.x = cvt_pk_bf16(h0[0] * g0[0], h0[1] * g0[1]); w.y = cvt_pk_bf16(h0[2] * g0[2], h0[3] * g0[3]); w.z = cvt_pk_bf16(h1[0] * g1[0], h1[1] * g1[1]); w.w = cvt_pk_bf16(h1[2] * g1[2], h1[3] * g1[3]);
                        *(u32x4*)(HG + row * ld + col) = w; } }
                ss += __shfl_xor(ss, 16); ss += __shfl_xor(ss, 32);
                if (fq == 0) atomicAdd(RS + row, ss); }
    }
};
struct EpiRowScale {
    static constexpr bool PERM = true, AFTER_DRAIN = false;
    bf16_t* O; int ldc; const float* RS; float sc;
    __device__ __forceinline__ void operator()(const f32x4 (&acc)[2][2][4][2], const Unit& u, int wr, int wc, int fr, int fq) const {
        const int row0 = u.pm * BM + wr * 64 + fr, col0 = u.pn * BM + wc * 32 + 8 * fq;
#pragma unroll
        for (int ai = 0; ai < 2; ++ai)
#pragma unroll
            for (int m = 0; m < 4; ++m) { const size_t row = (size_t)(row0 + ai * HALF + m * 16); const float rs = rsqrtf(RS[row] * (1.f / 4096.f) + 1e-6f) * sc;
#pragma unroll
                for (int bj = 0; bj < 2; ++bj) { const f32x4 v0 = acc[ai][bj][m][0] * rs, v1 = acc[ai][bj][m][1] * rs;
                    u32x4 w; w.x = cvt_pk_bf16(v0[0], v0[1]); w.y = cvt_pk_bf16(v0[2], v0[3]); w.z = cvt_pk_bf16(v1[0], v1[1]); w.w = cvt_pk_bf16(v1[2], v1[3]);
                    *(u32x4*)(O + row * ldc + col0 + bj * HALF) = w; } }
    }
};

template <bool ATOMIC> struct EpiF32 {
    static constexpr bool PERM = true, AFTER_DRAIN = false;
    float* O; int ldc;
    __device__ __forceinline__ void operator()(const f32x4 (&acc)[2][2][4][2], const Unit& u, int wr, int wc, int fr, int fq) const {
        const int row0 = u.pm * BM + wr * 64 + fr, col0 = u.pn * BM + wc * 32 + 8 * fq;
#pragma unroll
        for (int ai = 0; ai < 2; ++ai)
#pragma unroll
            for (int m = 0; m < 4; ++m) { float* rowp = O + (size_t)(row0 + ai * HALF + m * 16) * ldc + col0;
#pragma unroll
                for (int bj = 0; bj < 2; ++bj) {
                    if (ATOMIC) {
#pragma unroll
                        for (int e = 0; e < 4; ++e) { atomicAdd(rowp + bj * HALF + e, acc[ai][bj][m][0][e]); atomicAdd(rowp + bj * HALF + 4 + e, acc[ai][bj][m][1][e]); }
                    } else { *(f32x4*)(rowp + bj * HALF) = acc[ai][bj][m][0]; *(f32x4*)(rowp + bj * HALF + 4) = acc[ai][bj][m][1]; } } }
    }
};
template <class Epi, class Sched, bool ALIGN_EPI = false, bool SP2 = false>
__device__ __forceinline__ void gemm_phase(PG8_LAS unsigned char* lds, const Gemm g, const Sched& S, const Epi& E) {
    const int tid = threadIdx.x, wid = __builtin_amdgcn_readfirstlane(tid >> 6), lane = tid & 63, wr = wid >> 2, wc = wid & 3, fr = lane & 15, fq = lane >> 4;
    const int K = g.K, nt = K / BK, LD = g.ld ? g.ld : g.K;
    unsigned voffA[2], voffB[2];
#pragma unroll
    for (int i = 0; i < 2; ++i) { int R, C; stage_rc(tid * 16 + i * 8192, R, C); const int Rb = Epi::PERM ? ((R & ~31) + perm32(R & 31)) : R;
        voffA[i] = (unsigned)(R * LD + C) * 2u; voffB[i] = (unsigned)(Rb * LD + C) * 2u; }
    const size_t kstep = (size_t)(BK * 2);
    const size_t hstep = (size_t)HALF * LD * 2;
    const size_t tstep = 2 * hstep;
    const unsigned ldsw = (unsigned)wid * 1024u;
    const int aoff = lds_byte(wr * 64 + fr, fq * 8), boff = lds_byte(wc * 32 + fr, fq * 8);
#define PG8_SA(b, h) (((b) * 2 + (h)) * HTB)
#define PG8_SB(b, h) ((4 + (b) * 2 + (h)) * HTB)
#define PG8_STAGE(bufoff, gbase, voff) do { _Pragma("unroll") for (int _i = 0; _i < 2; ++_i) \
        __builtin_amdgcn_global_load_lds((const unsigned*)((const char*)(gbase) + (voff)[_i]), (PG8_LAS unsigned*)(lds + (bufoff) + ldsw + _i * 8192), 16, 0, 0); } while (0)
#define PG8_LDA(dst, b, h) do { _Pragma("unroll") for (int m = 0; m < 4; ++m) _Pragma("unroll") for (int k = 0; k < 2; ++k) dst[m][k] = *(const PG8_LAS bf16x8*)(lds + PG8_SA(b, h) + aoff + m * 2048 + k * 1024); } while (0)
#define PG8_LDB(dst, b, h) do { _Pragma("unroll") for (int n = 0; n < 2; ++n) _Pragma("unroll") for (int k = 0; k < 2; ++k) dst[n][k] = *(const PG8_LAS bf16x8*)(lds + PG8_SB(b, h) + boff + n * 2048 + k * 1024); } while (0)
#define PG8_MMA(ai, bj, At, Bt) do { __builtin_amdgcn_s_setprio(1); _Pragma("unroll") for (int m = 0; m < 4; ++m) _Pragma("unroll") for (int n = 0; n < 2; ++n) _Pragma("unroll") for (int k = 0; k < 2; ++k) \
        acc[ai][bj][m][n] = __builtin_amdgcn_mfma_f32_16x16x32_bf16(Bt[n][k], At[m][k], acc[ai][bj][m][n], 0, 0, 0); __builtin_amdgcn_s_setprio(0); } while (0)
#define PG8_WAIT_V(n) asm volatile("s_waitcnt vmcnt(" #n ")" ::: "memory")
#define PG8_WAIT_L(n) asm volatile("s_waitcnt lgkmcnt(" #n ")" ::: "memory")
#define PG8_BAR __builtin_amdgcn_s_barrier()
#define PG8_SCHED __builtin_amdgcn_sched_barrier(0)
    Unit cur, nxt; int ui = 0;
    if (!S.next(0, cur)) return;
    f32x4 acc[2][2][4][2];
#pragma unroll
    for (int a = 0; a < 2; ++a)
#pragma unroll
        for (int b = 0; b < 2; ++b)
#pragma unroll
            for (int m = 0; m < 4; ++m)
#pragma unroll
                for (int n = 0; n < 2; ++n) acc[a][b][m][n] = (f32x4){0.f, 0.f, 0.f, 0.f};
    bf16x8 At[4][2], B0[2][2], B1[2][2];
    const char* cA = (const char*)g.A + (size_t)cur.pm * tstep; const char* cB = (const char*)g.Bt + (size_t)cur.pn * tstep;
    S.a_ready(cur);
    if constexpr (SP2) {
        PG8_STAGE(PG8_SB(0, 0), cB, voffB); PG8_STAGE(PG8_SB(0, 1), cB + hstep, voffB); PG8_STAGE(PG8_SA(0, 0), cA, voffA); PG8_STAGE(PG8_SA(0, 1), cA + hstep, voffA);
        if (wr == 1) PG8_BAR;
        PG8_WAIT_V(2); PG8_BAR;
        PG8_STAGE(PG8_SB(1, 0), cB + kstep, voffB); PG8_STAGE(PG8_SA(1, 0), cA + kstep, voffA); PG8_STAGE(PG8_SB(1, 1), cB + hstep + kstep, voffB);
        PG8_WAIT_V(6); PG8_BAR;
    } else {
        PG8_STAGE(PG8_SB(0, 0), cB, voffB); PG8_STAGE(PG8_SA(0, 0), cA, voffA); PG8_STAGE(PG8_SB(0, 1), cB + hstep, voffB); PG8_STAGE(PG8_SA(0, 1), cA + hstep, voffA);
        if (wr == 1) PG8_BAR;
        PG8_WAIT_V(4); PG8_BAR;
        PG8_STAGE(PG8_SB(1, 0), cB + kstep, voffB); PG8_STAGE(PG8_SA(1, 0), cA + kstep, voffA); PG8_STAGE(PG8_SB(1, 1), cB + hstep + kstep, voffB);
        PG8_WAIT_V(6); PG8_BAR;
    }
    for (;;) {
        const bool has_next = S.next(ui + 1, nxt);
        const char* nA = has_next ? (const char*)g.A + (size_t)nxt.pm * tstep : cA; const char* nB = has_next ? (const char*)g.Bt + (size_t)nxt.pn * tstep : cB;
        for (int t = 0; t < nt; t += 2) {
            const bool last = (t == nt - 2);
            const char* a1 = cA + (size_t)(t + 1) * kstep;
            const char* a2 = last ? nA : cA + (size_t)(t + 2) * kstep; const char* b2 = last ? nB : cB + (size_t)(t + 2) * kstep;
            const char* a3 = a2 + kstep; const char* b3 = b2 + kstep;
            if (last && has_next) S.a_ready(nxt);
            if constexpr (SP2) {
            PG8_LDB(B0, 0, 0); PG8_LDB(B1, 0, 1); PG8_SCHED; PG8_LDA(At, 0, 0); PG8_STAGE(PG8_SA(1, 1), a1 + hstep, voffA);
            PG8_WAIT_V(8); PG8_WAIT_L(0); PG8_BAR; PG8_MMA(0, 0, At, B0); PG8_MMA(0, 1, At, B1); PG8_BAR; PG8_SCHED;
            PG8_LDA(At, 0, 1); PG8_STAGE(PG8_SB(0, 0), b2, voffB); PG8_STAGE(PG8_SB(0, 1), b2 + hstep, voffB); PG8_STAGE(PG8_SA(0, 0), a2, voffA);
            PG8_WAIT_V(8); PG8_WAIT_L(0); PG8_BAR; PG8_MMA(1, 0, At, B0); PG8_MMA(1, 1, At, B1); PG8_BAR; PG8_SCHED;
            PG8_LDB(B0, 1, 0); PG8_LDB(B1, 1, 1); PG8_SCHED; PG8_LDA(At, 1, 0); PG8_STAGE(PG8_SA(0, 1), a2 + hstep, voffA);
            PG8_WAIT_V(8); PG8_WAIT_L(0); PG8_BAR; PG8_MMA(0, 0, At, B0); PG8_MMA(0, 1, At, B1); PG8_BAR; PG8_SCHED;
            PG8_LDA(At, 1, 1); PG8_STAGE(PG8_SB(1, 0), b3, voffB); PG8_STAGE(PG8_SB(1, 1), b3 + hstep, voffB); PG8_STAGE(PG8_SA(1, 0), a3, voffA);
            PG8_WAIT_V(8); PG8_WAIT_L(0); PG8_BAR; PG8_MMA(1, 0, At, B0); PG8_MMA(1, 1, At, B1); PG8_BAR; PG8_SCHED;
            } else {
            PG8_LDB(B0, 0, 0); PG8_SCHED; PG8_LDA(At, 0, 0); PG8_STAGE(PG8_SA(1, 1), a1 + hstep, voffA);
            PG8_WAIT_L(8); PG8_BAR; PG8_WAIT_L(0); PG8_MMA(0, 0, At, B0); PG8_BAR; PG8_SCHED;
            PG8_LDB(B1, 0, 1); PG8_STAGE(PG8_SB(0, 0), b2, voffB);
            PG8_BAR; PG8_WAIT_L(0); PG8_MMA(0, 1, At, B1); PG8_BAR;
            PG8_LDA(At, 0, 1); PG8_STAGE(PG8_SA(0, 0), a2, voffA);
            PG8_BAR; PG8_WAIT_L(0); PG8_MMA(1, 0, At, B0); PG8_BAR; PG8_SCHED;
            PG8_STAGE(PG8_SB(0, 1), b2 + hstep, voffB);
            PG8_WAIT_V(6); PG8_BAR; PG8_MMA(1, 1, At, B1); PG8_BAR;
            PG8_LDB(B0, 1, 0); PG8_SCHED; PG8_LDA(At, 1, 0); PG8_STAGE(PG8_SA(0, 1), a2 + hstep, voffA);
            PG8_WAIT_L(8); PG8_BAR; PG8_WAIT_L(0); PG8_MMA(0, 0, At, B0); PG8_BAR; PG8_SCHED;
            PG8_LDB(B1, 1, 1); PG8_STAGE(PG8_SB(1, 0), b3, voffB);
            PG8_BAR; PG8_WAIT_L(0); PG8_MMA(0, 1, At, B1); PG8_BAR;
            PG8_LDA(At, 1, 1); PG8_STAGE(PG8_SA(1, 0), a3, voffA);
            PG8_BAR; PG8_WAIT_L(0); PG8_MMA(1, 0, At, B0); PG8_BAR; PG8_SCHED;
            PG8_STAGE(PG8_SB(1, 1), b3 + hstep, voffB);
            PG8_WAIT_V(6); PG8_BAR; PG8_MMA(1, 1, At, B1); PG8_BAR;
            }
        }
        if constexpr (ALIGN_EPI) { if (wr == 0) PG8_BAR; }
        if constexpr (!Epi::AFTER_DRAIN) { E(acc, cur, wr, wc, fr, fq); S.done(cur); }
        if (!has_next) break;
#pragma unroll
        for (int a = 0; a < 2; ++a)
#pragma unroll
            for (int b = 0; b < 2; ++b)
#pragma unroll
                for (int m = 0; m < 4; ++m)
#pragma unroll
                    for (int n = 0; n < 2; ++n) acc[a][b][m][n] = (f32x4){0.f, 0.f, 0.f, 0.f};
        cur = nxt; cA = nA; cB = nB; ++ui;
        if constexpr (ALIGN_EPI) { if (wr == 1) PG8_BAR; }
    }
    PG8_WAIT_V(0);
    if constexpr (!ALIGN_EPI) { if (wr == 0) PG8_BAR; }
    PG8_BAR;
    if constexpr (Epi::AFTER_DRAIN) { E.fused(acc, cur, wr, wc, fr, fq, lds, wid, lane); S.done(cur); }
#undef PG8_SA
#undef PG8_SB
#undef PG8_STAGE
#undef PG8_LDA
#undef PG8_LDB
#undef PG8_MMA
#undef PG8_WAIT_V
#undef PG8_WAIT_L
#undef PG8_BAR
#undef PG8_SCHED
}
}

#define LAS __attribute__((address_space(3)))
typedef pg8::bf16_t bf16_t;
typedef pg8::bf16x8 bf16x8;
typedef pg8::f32x4 f32x4;
typedef pg8::u32x4 u32x4;
typedef float f32x16 __attribute__((ext_vector_type(16)));
typedef short s16x4 __attribute__((ext_vector_type(4)));
typedef int i32x4 __attribute__((ext_vector_type(4)));

constexpr int SEQ = 8192, DM = 4096, INW = 36864, MEML = 256;
constexpr int C_Q = 0, C_K = 4096, C_V = 8192, C_ZA = 12288, C_UB = 16384, C_VB = 20480, C_ZB = 24576, C_G = 28672;
constexpr float LOG2E = 1.4426950408889634f;
constexpr float QSCALE = 0.08838834764831845f * LOG2E;
constexpr float EPS = 1e-6f;

constexpr size_t MiB = 1u << 20;
constexpr size_t WS_RS = 0, WS_RS2 = 32768, WS_TMETA = 65536, WS_BAR = 131072, BAR_BYTES = 16384;
constexpr size_t WS_WIN = 1 * MiB;
constexpr size_t WS_WPA = WS_WIN + 288 * MiB, WS_WPB = WS_WPA + 32 * MiB, WS_WOUT = WS_WPB + 32 * MiB;
constexpr size_t WS_WXQ = WS_WOUT + 32 * MiB, WS_WXKV = WS_WXQ + 4 * MiB, WS_WXO = WS_WXKV + 8 * MiB;
constexpr size_t WS_HN = WS_WXO + 4 * MiB;
constexpr size_t WS_MN = WS_HN + 64 * MiB;
constexpr size_t WS_PROJ = WS_MN + 2 * MiB;
constexpr size_t WS_AA = WS_PROJ + 576 * MiB, WS_AB = WS_AA + 64 * MiB;
constexpr size_t WS_TMP = WS_AB + 64 * MiB;
constexpr size_t WS_MRG = WS_TMP + 128 * MiB;
constexpr size_t WS_H1 = WS_MRG + 64 * MiB;
constexpr size_t WS_HG = WS_H1 + 128 * MiB;
constexpr size_t WS_QX = WS_HG + 64 * MiB;
constexpr size_t WS_KVX = WS_QX + 8 * MiB;
constexpr size_t WS_OX = WS_KVX + 1 * MiB;
constexpr size_t WS_KVF = WS_OX + 8 * MiB;
constexpr size_t WS_END = WS_KVF + 16 * MiB;

constexpr int STAGE = 65536;
constexpr int LUT_OFF = 131072, WSF_OFF = 131072 + 1024, SS_OFF = 131072 + 2048, TM_OFF = 131072 + 3072, POSK_OFF = 131072 + 4096, XM_OFF = 131072 + 4608, PB_OFF = 131072 + 4608 + 4096, XBST_OFF = 131072 + 4608 + 4096 + 16384, FLAG_OFF = 131072 + 4608 + 4096 + 16384 + 16, LDS_BYTES = 131072 + 4608 + 4096 + 16384 + 16 + 64;

struct Args {
    const float *x; const int* pos; const float *mem, *w_in, *b_gate, *norm1_g, *lq1, *lk1, *lq2, *lk2, *subln_g, *rel_bias, *sg_ln_g, *sg_ln_b, *sg_w, *sg_b,
                *w_pa, *w_pb, *w_out, *norm_x_g, *norm_mem_g, *w_xq, *w_xkv, *w_xo, *final_g;
    float* out; unsigned char* ws; int lo, hi;
};

__device__ __forceinline__ float wave_sum(float v) {
#pragma unroll
    for (int o = 1; o < 64; o <<= 1) v += __shfl_xor(v, o);
    return v;
}
__device__ __forceinline__ unsigned pk2(float lo, float hi) { return pg8::cvt_pk_bf16(lo, hi); }
__device__ __forceinline__ float bf2f(unsigned b) { return __uint_as_float(b << 16); }
__device__ __forceinline__ void glds16(const void* g, LAS unsigned char* l) { unsigned keep; const unsigned dst = (unsigned)__builtin_amdgcn_readfirstlane((int)(unsigned)(uintptr_t)l);
    asm volatile("s_mov_b32 %0, m0\n\ts_mov_b32 m0, %2\n\ts_nop 0\n\tglobal_load_lds_dwordx4 %1, off\n\ts_mov_b32 m0, %0" : "=&s"(keep) : "v"(g), "s"(dst) : "memory"); }
__device__ __forceinline__ s16x4 trr(const LAS unsigned char* p) { return __builtin_bit_cast(s16x4, __builtin_amdgcn_ds_read_tr16_b64_v4i16((LAS s16x4*)p)); }
__device__ __forceinline__ int crow(int r, int hi) { return (r & 3) + 8 * (r >> 2) + 4 * hi; }

__device__ __forceinline__ void p0_transpose_item(const float* W, int K, int N, bf16_t* WT, LAS float* scr, int item, int lane) {
    const int nblk = N / 32, kb = item / nblk, nb = item % nblk, k0 = 64 * kb, n0 = 32 * nb;
    float wv[32];
#pragma unroll
    for (int i = 0; i < 32; ++i) wv[i] = W[(size_t)(k0 + 2 * i + (lane >> 5)) * N + n0 + (lane & 31)];
#pragma unroll
    for (int i = 0; i < 32; ++i) scr[(2 * i + (lane >> 5)) * 33 + (lane & 31)] = wv[i];
    __builtin_amdgcn_fence(__ATOMIC_RELEASE, "wavefront"); asm volatile("s_waitcnt lgkmcnt(0)" ::: "memory");
    const int c = lane & 7;
#pragma unroll
    for (int j = 0; j < 4; ++j) { const int n = (lane >> 3) + 8 * j; const LAS float* s = scr + (8 * c) * 33 + n;
        u32x4 o; o.x = pk2(s[0 * 33], s[1 * 33]); o.y = pk2(s[2 * 33], s[3 * 33]); o.z = pk2(s[4 * 33], s[5 * 33]); o.w = pk2(s[6 * 33], s[7 * 33]);
        *(u32x4*)(WT + (size_t)(n0 + n) * K + k0 + 8 * c) = o; }
    asm volatile("s_waitcnt lgkmcnt(0)" ::: "memory");
}
__device__ __forceinline__ void rms_row_to_bf16(const float* xrow, const float* g, bf16_t* orow, int lane) {
    const f32x4* xr = (const f32x4*)xrow + lane; const f32x4* gr = (const f32x4*)g + lane;
    f32x4 v[16]; float s = 0.f;
#pragma unroll
    for (int j = 0; j < 16; ++j) { v[j] = xr[64 * j]; s += (v[j].x * v[j].x + v[j].y * v[j].y) + (v[j].z * v[j].z + v[j].w * v[j].w); }
    const float rstd = rsqrtf(wave_sum(s) * (1.f / 4096.f) + EPS);
    unsigned long long* o8 = (unsigned long long*)orow + lane;
#pragma unroll
    for (int j = 0; j < 16; ++j) { const f32x4 gg = gr[64 * j];
        o8[64 * j] = (unsigned long long)pk2(v[j].x * rstd * gg.x, v[j].y * rstd * gg.y) | ((unsigned long long)pk2(v[j].z * rstd * gg.z, v[j].w * rstd * gg.w) << 32); }
}

__device__ __forceinline__ void glds4(const void* g, LAS unsigned char* l) { unsigned keep; const unsigned dst = (unsigned)__builtin_amdgcn_readfirstlane((int)(unsigned)(uintptr_t)l);
    asm volatile("s_mov_b32 %0, m0\n\ts_mov_b32 m0, %2\n\ts_nop 0\n\tglobal_load_lds_dword %1, off\n\ts_mov_b32 m0, %0" : "=&s"(keep) : "v"(g), "s"(dst) : "memory"); }
template <int NVB>
__device__ __forceinline__ void attn_dma(LAS unsigned char* st, int wid, int lane, const bf16_t* K0, const bf16_t* K1, size_t kpitch, const bf16_t* V, size_t vpitch) {
#pragma unroll
    for (int i2 = 0; i2 < 2; ++i2) { const int i = wid * 2 + i2, row = 4 * i + (lane >> 4), pc = lane & 15, lc = pc ^ (row & 15);
        glds16(K0 + (size_t)row * kpitch + lc * 8, st + i * 1024);
        glds16(K1 + (size_t)row * kpitch + lc * 8, st + 16384 + i * 1024); }
    if (NVB == 8) {
#pragma unroll
        for (int i4 = 0; i4 < 4; ++i4) { const int i = wid * 4 + i4, row = 2 * i + (lane >> 5), pc = lane & 31, lc = pc ^ ((row & 7) << 2);
            glds16(V + (size_t)row * vpitch + lc * 8, st + 32768 + i * 1024); }
    } else {
#pragma unroll
        for (int i2 = 0; i2 < 2; ++i2) { const int i = wid * 2 + i2, row = 4 * i + (lane >> 4), pc = lane & 15, lc = pc ^ ((row & 3) << 2);
            glds16(V + (size_t)row * vpitch + lc * 8, st + 32768 + i * 1024); }
    }
}

template <int NO, int NVB, bool MASKED>
__device__ __forceinline__ void attn_tile(bool NEAR, const LAS unsigned char* Kst, const LAS unsigned char* Vst, const bf16x8 (&qf)[8], f32x16 (&O)[NO], float& m_ref, float& l_part,
                                          LAS float* wsf, int lane, const LAS int* posk, int qpos, const LAS float* lut, int cbase) {
    const int r32 = lane & 31, h = lane >> 5;
    const LAS unsigned char* kb_ = Kst + r32 * 256;
    const int sw = r32 & 15;
    constexpr int ROWB = NVB * 64;
    const int blk = (lane >> 4) & 1, q = (lane & 15) >> 2, p = lane & 3;
    const int swl = (NVB == 8) ? (4 * h + q) : q;
    const LAS unsigned char* vb = Vst + (4 * h + q) * ROWB + blk * 32 + p * 8;
    const float nm = -m_ref;
    f32x16 S0 = {nm, nm, nm, nm, nm, nm, nm, nm, nm, nm, nm, nm, nm, nm, nm, nm}, S1 = S0;
#pragma unroll
    for (int dg = 0; dg < 2; ++dg) {
        bf16x8 kf0[4], kf1[4];
#pragma unroll
        for (int d = 0; d < 4; ++d) { const int co = ((2 * (4 * dg + d) + h) ^ sw) << 4; kf0[d] = *(const LAS bf16x8*)(kb_ + co); kf1[d] = *(const LAS bf16x8*)(kb_ + 8192 + co); }
        __builtin_amdgcn_sched_barrier(0);
#pragma unroll
        for (int d = 0; d < 4; ++d) {
            S0 = __builtin_amdgcn_mfma_f32_32x32x16_bf16(kf0[d], qf[4 * dg + d], S0, 0, 0, 0);
            S1 = __builtin_amdgcn_mfma_f32_32x32x16_bf16(kf1[d], qf[4 * dg + d], S1, 0, 0, 0);
        }
        __builtin_amdgcn_sched_barrier(0);
    }
    if (MASKED && NEAR) {
        float b0[16], b1[16];
#pragma unroll
        for (int g4 = 0; g4 < 4; ++g4) { const i32x4 pk0 = *(const LAS i32x4*)(posk + 8 * g4 + 4 * h), pk1 = *(const LAS i32x4*)(posk + 32 + 8 * g4 + 4 * h);
#pragma unroll
            for (int i = 0; i < 4; ++i) { const int rel0 = qpos - pk0[i], rel1 = qpos - pk1[i];
                b0[4 * g4 + i] = lut[rel0 < 0 ? 129 : (rel0 > 128 ? 128 : rel0)]; b1[4 * g4 + i] = lut[rel1 < 0 ? 129 : (rel1 > 128 ? 128 : rel1)]; } }
#pragma unroll
        for (int r = 0; r < 16; ++r) { S0[r] += b0[r]; S1[r] += b1[r]; }
    }
    float mt = fmaxf(S0[0], S1[0]);
#pragma unroll
    for (int r = 1; r < 16; ++r) mt = fmaxf(mt, fmaxf(S0[r], S1[r]));
    mt = fmaxf(mt, __shfl_xor(mt, 32));
    const bool need = mt > 8.f;
    if (__any(need)) {
        const float dl = need ? mt : 0.f;
        const float alpha = pg8::ex2_(-dl);
        l_part *= alpha; m_ref += dl;
#pragma unroll
        for (int r = 0; r < 16; ++r) { S0[r] -= dl; S1[r] -= dl; }
        wsf[r32] = alpha;
#pragma unroll
        for (int g4 = 0; g4 < 4; ++g4) { const f32x4 a = *(const LAS f32x4*)(wsf + 8 * g4 + 4 * h);
#pragma unroll
            for (int c = 0; c < NO; ++c)
#pragma unroll
                for (int i = 0; i < 4; ++i) O[c][4 * g4 + i] *= a[i]; }
    }
    float ls = 0.f;
#pragma unroll
    for (int r = 0; r < 16; ++r) { const float p0 = pg8::ex2_(S0[r]), p1 = pg8::ex2_(S1[r]); S0[r] = p0; S1[r] = p1; ls += p0 + p1; }
    l_part += ls;
    bf16x8 pa[2][2];
#pragma unroll
    for (int ks = 0; ks < 2; ++ks) {
        u32x4 w; w.x = pk2(S0[8 * ks + 0], S0[8 * ks + 1]); w.y = pk2(S0[8 * ks + 2], S0[8 * ks + 3]); w.z = pk2(S0[8 * ks + 4], S0[8 * ks + 5]); w.w = pk2(S0[8 * ks + 6], S0[8 * ks + 7]); pa[0][ks] = __builtin_bit_cast(bf16x8, w);
        u32x4 x; x.x = pk2(S1[8 * ks + 0], S1[8 * ks + 1]); x.y = pk2(S1[8 * ks + 2], S1[8 * ks + 3]); x.z = pk2(S1[8 * ks + 4], S1[8 * ks + 5]); x.w = pk2(S1[8 * ks + 6], S1[8 * ks + 7]); pa[1][ks] = __builtin_bit_cast(bf16x8, x); }
    __builtin_amdgcn_sched_barrier(0);
    {
        bf16x8 vf[2][NO];
#define LOADV(buf, g) do { _Pragma("unroll") for (int c = 0; c < NO; ++c) { const LAS unsigned char* a0 = vb + (16 * (g)) * ROWB + (((c + cbase) ^ swl) << 6); \
            const s16x4 lo = trr(a0), hi = trr(a0 + 8 * ROWB); vf[buf][c] = (bf16x8){lo[0], lo[1], lo[2], lo[3], hi[0], hi[1], hi[2], hi[3]}; } } while (0)
        LOADV(0, 0);
#pragma unroll
        for (int g = 0; g < 4; ++g) {
            if (g + 1 < 4) LOADV((g + 1) & 1, g + 1);
            __builtin_amdgcn_sched_barrier(0);
#pragma unroll
            for (int c = 0; c < NO; ++c) O[c] = __builtin_amdgcn_mfma_f32_32x32x16_bf16(pa[g >> 1][g & 1], vf[g & 1][c], O[c], 0, 0, 0);
            __builtin_amdgcn_sched_barrier(0);
        }
#undef LOADV
    }
}

__device__ __forceinline__ void attn_tile_pair(bool NEAR, bool first, int par, const LAS unsigned char* Kst, const LAS unsigned char* Vst, const bf16x8 (&qf)[8], f32x16 (&O)[4], float& m_ref, float& l_part,
                                               LAS float* wsf, LAS float* xm, LAS unsigned char* pb, int wid, int lane, const LAS int* posk, int qpos, const LAS float* lut, int dh, volatile LAS int* flg, int seq) {
    const int r32 = lane & 31, h = lane >> 5;
    if (!first) {
        const float mt = fmaxf(xm[((par ^ 1) * 8 + wid) * 64 + r32], xm[((par ^ 1) * 8 + (wid ^ 2)) * 64 + r32]);
        const bool need = mt > 8.f;
        if (__any(need)) {
            const float dl = need ? mt : 0.f; const float alpha = pg8::ex2_(-dl);
            l_part *= alpha; m_ref += dl;
            wsf[r32] = alpha;
#pragma unroll
            for (int g4 = 0; g4 < 4; ++g4) { const f32x4 a = *(const LAS f32x4*)(wsf + 8 * g4 + 4 * h);
#pragma unroll
                for (int c = 0; c < 4; ++c)
#pragma unroll
                    for (int i = 0; i < 4; ++i) O[c][4 * g4 + i] *= a[i]; }
        }
    }
    const LAS unsigned char* kb_ = Kst + (32 * dh + r32) * 256;
    const int sw = r32 & 15;
    const float nm = -m_ref;
    f32x16 S = {nm, nm, nm, nm, nm, nm, nm, nm, nm, nm, nm, nm, nm, nm, nm, nm}, T = {0.f, 0.f, 0.f, 0.f, 0.f, 0.f, 0.f, 0.f, 0.f, 0.f, 0.f, 0.f, 0.f, 0.f, 0.f, 0.f};
    {
        bf16x8 kf[8];
#pragma unroll
        for (int d0 = 0; d0 < 8; ++d0) kf[d0] = *(const LAS bf16x8*)(kb_ + (((2 * d0 + h) ^ sw) << 4));
        __builtin_amdgcn_sched_barrier(0);
#pragma unroll
        for (int d = 0; d < 4; ++d) {
            S = __builtin_amdgcn_mfma_f32_32x32x16_bf16(kf[d], qf[d], S, 0, 0, 0);
            T = __builtin_amdgcn_mfma_f32_32x32x16_bf16(kf[4 + d], qf[4 + d], T, 0, 0, 0);
        }
    }
    __builtin_amdgcn_sched_barrier(0);
#pragma unroll
    for (int r = 0; r < 16; ++r) S[r] += T[r];
    if (NEAR) {
        float b0[16];
#pragma unroll
        for (int g4 = 0; g4 < 4; ++g4) { const i32x4 pk0 = *(const LAS i32x4*)(posk + 32 * dh + 8 * g4 + 4 * h);
#pragma unroll
            for (int i = 0; i < 4; ++i) { const int rel0 = qpos - pk0[i]; b0[4 * g4 + i] = lut[rel0 < 0 ? 129 : (rel0 > 128 ? 128 : rel0)]; } }
#pragma unroll
        for (int r = 0; r < 16; ++r) S[r] += b0[r];
    }
    float mt = S[0];
#pragma unroll
    for (int r = 1; r < 16; ++r) mt = fmaxf(mt, S[r]);
    { auto rr = __builtin_amdgcn_permlane32_swap(__float_as_uint(mt), __float_as_uint(mt), false, false); mt = fmaxf(__uint_as_float(rr[0]), __uint_as_float(rr[1])); }
    xm[(par * 8 + wid) * 64 + r32] = mt;
    float ls = 0.f;
#pragma unroll
    for (int r = 0; r < 16; ++r) { const float p0 = pg8::ex2_(S[r]); S[r] = p0; ls += p0; }
    l_part += ls;
    u32x4 mine[2];
#pragma unroll
    for (int ks = 0; ks < 2; ++ks) { mine[ks].x = pk2(S[8 * ks + 0], S[8 * ks + 1]); mine[ks].y = pk2(S[8 * ks + 2], S[8 * ks + 3]); mine[ks].z = pk2(S[8 * ks + 4], S[8 * ks + 5]); mine[ks].w = pk2(S[8 * ks + 6], S[8 * ks + 7]);
        *(LAS u32x4*)(pb + ((wid * 2 + ks) * 64 + lane) * 16) = mine[ks]; }
    const int blk = (lane >> 4) & 1, q = (lane & 15) >> 2, p = lane & 3;
    const int swl = 4 * h + q, cbase = 4 * dh;
    const LAS unsigned char* vb = Vst + (4 * h + q) * 512 + blk * 32 + p * 8;
    const int gown = 2 * dh, goth = 2 * (dh ^ 1);
    bf16x8 vf[2][4];
#define LOADV(buf, g) do { _Pragma("unroll") for (int c = 0; c < 4; ++c) { const LAS unsigned char* a0 = vb + (g) * 8192 + (((c + cbase) ^ swl) << 6); \
        const s16x4 lo = trr(a0), hi = trr(a0 + 8 * 512); vf[buf][c] = (bf16x8){lo[0], lo[1], lo[2], lo[3], hi[0], hi[1], hi[2], hi[3]}; } } while (0)
#define PVMMA(buf, P) do { _Pragma("unroll") for (int c = 0; c < 4; ++c) O[c] = __builtin_amdgcn_mfma_f32_32x32x16_bf16(__builtin_bit_cast(bf16x8, P), vf[buf][c], O[c], 0, 0, 0); } while (0)
    LOADV(0, gown);
    asm volatile("" ::: "memory");
    flg[wid] = seq;
    asm volatile("" ::: "memory");
    LOADV(1, gown + 1); __builtin_amdgcn_sched_barrier(0); PVMMA(0, mine[0]); __builtin_amdgcn_sched_barrier(0);
    LOADV(0, goth);     __builtin_amdgcn_sched_barrier(0); PVMMA(1, mine[1]); __builtin_amdgcn_sched_barrier(0);
    while (flg[wid ^ 2] != seq) __builtin_amdgcn_s_sleep(1);
    asm volatile("" ::: "memory");
    u32x4 oth[2];
#pragma unroll
    for (int ks = 0; ks < 2; ++ks) oth[ks] = *(const LAS u32x4*)(pb + (((wid ^ 2) * 2 + ks) * 64 + lane) * 16);
    LOADV(1, goth + 1); __builtin_amdgcn_sched_barrier(0); PVMMA(0, oth[0]); __builtin_amdgcn_sched_barrier(0);
    PVMMA(1, oth[1]);
#undef PVMMA
#undef LOADV
}

template <int NVB>
__device__ __forceinline__ void scale_rows(f32x16 (&O)[NVB], float val, LAS float* wsf, int lane) {
    const int r32 = lane & 31, h = lane >> 5;
    wsf[r32] = val;
#pragma unroll
    for (int g4 = 0; g4 < 4; ++g4) { const f32x4 a = *(const LAS f32x4*)(wsf + 8 * g4 + 4 * h);
#pragma unroll
        for (int c = 0; c < NVB; ++c)
#pragma unroll
            for (int i = 0; i < 4; ++i) O[c][4 * g4 + i] *= a[i]; }
}

__device__ __forceinline__ int next_tile(const LAS int* tmin, int j, int qmax) { while (j < 128 && tmin[j] > qmax) ++j; return j; }

__device__ __forceinline__ void diff_attn_unit(LAS unsigned char* lds, const Args& A, int h, int qb, float lam, int tid, int wid, int lane) {
    asm volatile("" : "+v"(tid), "+v"(lane), "+s"(wid));
    const bf16_t* PROJ = (const bf16_t*)(A.ws + WS_PROJ); bf16_t* AA = (bf16_t*)(A.ws + WS_AA);
    const LAS int* tmin = (const LAS int*)(lds + TM_OFF); const LAS int* tmax = tmin + 128;
    const int grp = wid >> 2, wsub = wid & 3, rb = wsub & 1, dh = wsub >> 1, r32 = lane & 31, hh = lane >> 5;
    LAS float* lut = (LAS float*)(lds + LUT_OFF);
    LAS float* wsf = (LAS float*)(lds + WSF_OFF) + wid * 32;
    LAS float* SS = (LAS float*)(lds + SS_OFF);
    if (tid == 129) lut[129] = -INFINITY;
    if (tid < 129) { const int n = tid; float v = 0.f;
        if (n < 128) { int b; if (n < 16) b = n; else { const float lg = logf((float)n * (1.f / 16.f)) / 2.0794415416798357f * 16.f; b = 16 + (int)lg; b = b > 31 ? 31 : b; }
            v = (A.rel_bias[b * 16 + h] - A.rel_bias[31 * 16 + h]) * LOG2E; }
        lut[n] = v; }
    const int row0 = qb * 64, myrow = row0 + 32 * rb + r32;
    const bf16_t* Qp = PROJ + (size_t)myrow * INW + C_Q + h * 256 + grp * 128 + 8 * hh;
    bf16x8 qf[8];
#pragma unroll
    for (int d0 = 0; d0 < 8; ++d0) qf[d0] = *(const bf16x8*)(Qp + 16 * d0);
    const int qpos = A.pos[myrow];
    const bf16_t* Kb0 = PROJ + C_K + h * 256; const bf16_t* Kb1 = Kb0 + 128; const bf16_t* Vb = PROJ + C_V + h * 256;
    const int qmin = tmin[qb], qmax = tmax[qb];
    f32x16 O[4];
#pragma unroll
    for (int c = 0; c < 4; ++c)
#pragma unroll
        for (int r = 0; r < 16; ++r) O[c][r] = 0.f;
    float m_ref = 0.f, l_part = 0.f;
    int j = next_tile(tmin, 0, qmax), s = 0, seq = 0; bool first = true;
    volatile LAS int* flg = (volatile LAS int*)(lds + FLAG_OFF);
    flg[wid] = 0;
    __syncthreads();
    if (j < 128) attn_dma<8>(lds, wid, lane, Kb0 + (size_t)j * 64 * INW, Kb1 + (size_t)j * 64 * INW, INW, Vb + (size_t)j * 64 * INW, INW);
    if (j < 128 && wid == 0) glds4(A.pos + j * 64 + lane, lds + POSK_OFF);
    while (j < 128) {
        asm volatile("s_waitcnt vmcnt(0)" ::: "memory"); __syncthreads();
        const int jn = next_tile(tmin, j + 1, qmax);
        if (jn < 128) attn_dma<8>(lds + (s ^ 1) * STAGE, wid, lane, Kb0 + (size_t)jn * 64 * INW, Kb1 + (size_t)jn * 64 * INW, INW, Vb + (size_t)jn * 64 * INW, INW);
        if (jn < 128 && wid == 0) glds4(A.pos + jn * 64 + lane, lds + POSK_OFF + (s ^ 1) * 256);
        const bool near = (qmin - tmax[j]) < 128;
        const LAS unsigned char* st = lds + s * STAGE;
        attn_tile_pair(near, first, s, st + grp * 16384, st + 32768, qf, O, m_ref, l_part, wsf, (LAS float*)(lds + XM_OFF), lds + PB_OFF, wid, lane, (const LAS int*)(lds + POSK_OFF + s * 256), qpos, lut, dh, flg, ++seq);
        first = false; j = jn; s ^= 1;
    }
    float lt = l_part + __shfl_xor(l_part, 32);
    { LAS float* xl = (LAS float*)(lds + XM_OFF); __syncthreads(); xl[wid * 64 + r32] = lt; __syncthreads(); lt += xl[(wid ^ 2) * 64 + r32]; }
    scale_rows<4>(O, pg8::rcp_(lt) * (grp ? lam : 1.f), wsf, lane);
    __syncthreads();
    LAS float* X = (LAS float*)lds;
    if (grp == 1) {
#pragma unroll
        for (int c = 0; c < 4; ++c)
#pragma unroll
            for (int r = 0; r < 16; ++r) X[((wsub * 4 + c) * 16 + r) * 64 + lane] = O[c][r];
    }
    __syncthreads();
    float ss[16];
    if (grp == 0) {
#pragma unroll
        for (int r = 0; r < 16; ++r) ss[r] = 0.f;
#pragma unroll
        for (int c = 0; c < 4; ++c)
#pragma unroll
            for (int r = 0; r < 16; ++r) { const float o = O[c][r] - X[((wsub * 4 + c) * 16 + r) * 64 + lane]; O[c][r] = o; ss[r] += o * o; }
#pragma unroll
        for (int r = 0; r < 16; ++r) { float v = ss[r]; v += __shfl_xor(v, 1); v += __shfl_xor(v, 2); v += __shfl_xor(v, 4); v += __shfl_xor(v, 8); v += __shfl_xor(v, 16); ss[r] = v;
            if (r32 == 0) SS[(wsub * 2 + hh) * 16 + r] = v; }
    }
    __syncthreads();
    if (grp == 0) {
#pragma unroll
        for (int r = 0; r < 16; ++r) ss[r] = rsqrtf((ss[r] + SS[((wsub ^ 2) * 2 + hh) * 16 + r]) * (1.f / 256.f) + EPS) * 0.8f;
        const bf16_t* zb = PROJ + (size_t)(row0 + 32 * rb + 4 * hh) * INW + C_ZA + h * 256 + 128 * dh + r32;
        bf16_t* ob = AA + (size_t)(row0 + 32 * rb + 4 * hh) * DM + h * 256 + 128 * dh + r32;
#pragma unroll
        for (int c = 0; c < 4; ++c) { const float gs = A.subln_g[128 * dh + 32 * c + r32];
            unsigned zz[16];
#pragma unroll
            for (int r = 0; r < 16; ++r) { const int rr = (r & 3) + 8 * (r >> 2); zz[r] = zb[(size_t)rr * INW + 32 * c]; }
#pragma unroll
            for (int r = 0; r < 16; ++r) { const int rr = (r & 3) + 8 * (r >> 2);
                ob[(size_t)rr * DM + 32 * c] = (bf16_t)(pk2(O[c][r] * ss[r] * gs * bf2f(zz[r]), 0.f) & 0xffffu); }
            __builtin_amdgcn_sched_barrier(0);
        }
    }
    __syncthreads();
}

__device__ __forceinline__ void cross_attn_unit(LAS unsigned char* lds, const Args& A, int h, int qb, int tid, int wid, int lane) {
    asm volatile("" : "+v"(tid), "+v"(lane), "+s"(wid));
    const bf16_t* QX = (const bf16_t*)(A.ws + WS_QX); const bf16_t* KVX = (const bf16_t*)(A.ws + WS_KVX); bf16_t* OX = (bf16_t*)(A.ws + WS_OX);
    const int grp = wid >> 2, wsub = wid & 3, r32 = lane & 31, hh = lane >> 5;
    LAS float* wsf = (LAS float*)(lds + WSF_OFF) + wid * 32;
    const int row0 = qb * 256 + grp * 128 + 32 * wsub, myrow = row0 + r32;
    const float* Qp = (const float*)(A.ws + WS_TMP) + (size_t)myrow * 512 + h * 128 + 8 * hh;
    const float qrs = rsqrtf(((const float*)(A.ws + WS_RS))[myrow] * (1.f / 4096.f) + EPS) * QSCALE;
    bf16x8 qf[8];
#pragma unroll
    for (int d0 = 0; d0 < 8; ++d0) { f32x4 a0 = {0.f, 0.f, 0.f, 0.f}, a1 = a0;
#pragma unroll
        for (int ks = 0; ks < 4; ++ks) { a0 += *(const f32x4*)(Qp + (size_t)ks * SEQ * 512 + 16 * d0); a1 += *(const f32x4*)(Qp + (size_t)ks * SEQ * 512 + 16 * d0 + 4); }
        u32x4 w; w.x = pk2(a0[0] * qrs, a0[1] * qrs); w.y = pk2(a0[2] * qrs, a0[3] * qrs); w.z = pk2(a1[0] * qrs, a1[1] * qrs); w.w = pk2(a1[2] * qrs, a1[3] * qrs);
        qf[d0] = __builtin_bit_cast(bf16x8, w); }
    const bf16_t* Kb = KVX + h * 128; const bf16_t* Vb = KVX + 512 + h * 128;
    f32x16 O[4];
#pragma unroll
    for (int c = 0; c < 4; ++c)
#pragma unroll
        for (int r = 0; r < 16; ++r) O[c][r] = 0.f;
    float m_ref = 0.f, l_part = 0.f;
    __syncthreads();
    attn_dma<4>(lds, wid, lane, Kb, Kb, 1024, Vb, 1024);
    int s = 0;
    for (int j = 0; j < 4; ++j) {
        asm volatile("s_waitcnt vmcnt(0)" ::: "memory"); __syncthreads();
        if (j + 1 < 4) attn_dma<4>(lds + (s ^ 1) * STAGE, wid, lane, Kb + (size_t)(j + 1) * 64 * 1024, Kb + (size_t)(j + 1) * 64 * 1024, 1024, Vb + (size_t)(j + 1) * 64 * 1024, 1024);
        const LAS unsigned char* st = lds + s * STAGE;
        attn_tile<4, 4, false>(false, st + grp * 16384, st + 32768, qf, O, m_ref, l_part, wsf, lane, (const LAS int*)(lds + POSK_OFF), 0, (const LAS float*)(lds + LUT_OFF), 0);
        s ^= 1;
    }
    const float lt = l_part + __shfl_xor(l_part, 32);
    scale_rows<4>(O, pg8::rcp_(lt), wsf, lane);
#pragma unroll
    for (int c = 0; c < 4; ++c)
#pragma unroll
        for (int r = 0; r < 16; ++r) OX[(size_t)(row0 + crow(r, hh)) * 512 + h * 128 + 32 * c + r32] = (bf16_t)(pk2(O[c][r], 0.f) & 0xffffu);
    __syncthreads();
}

__device__ __forceinline__ void mixb_unit(LAS unsigned char* lds, const Args& A, int n, int gq, int tid, int wid, int lane) {
    asm volatile("" : "+v"(tid), "+v"(lane), "+s"(wid));
    const bf16_t* PROJ = (const bf16_t*)(A.ws + WS_PROJ); bf16_t* AB = (bf16_t*)(A.ws + WS_AB);
    LAS float* stats = (LAS float*)(lds + 98304);
    const int r32 = lane & 31, hh = lane >> 5;
    __syncthreads();
    for (int rr = 0; rr < 16; ++rr) {
        const int trow = 16 * wid + rr; const bf16_t* src = PROJ + (size_t)(128 * n + trow) * INW + C_VB;
        u32x4 v[8]; float s = 0.f;
#pragma unroll
        for (int j = 0; j < 8; ++j) { v[j] = *(const u32x4*)(src + (lane + 64 * j) * 8);
            s += (bf2f(v[j].x & 0xffffu) + bf2f(v[j].x >> 16)) + (bf2f(v[j].y & 0xffffu) + bf2f(v[j].y >> 16)) + (bf2f(v[j].z & 0xffffu) + bf2f(v[j].z >> 16)) + (bf2f(v[j].w & 0xffffu) + bf2f(v[j].w >> 16)); }
        const float mean = wave_sum(s) * (1.f / 4096.f); float q = 0.f;
#pragma unroll
        for (int j = 0; j < 8; ++j) {
#pragma unroll
            for (int e = 0; e < 4; ++e) { const unsigned w = v[j][e]; const float a = bf2f(w & 0xffffu) - mean, b = bf2f(w >> 16) - mean; q += a * a + b * b; } }
        const float rstd = rsqrtf(wave_sum(q) * (1.f / 4096.f) + EPS);
        if (lane == 0) { stats[2 * trow] = mean; stats[2 * trow + 1] = rstd; }
    }
    __syncthreads();
    for (int gi = 0; gi < 4; ++gi) {
        const int g = gq * 4 + gi;
#pragma unroll
        for (int i = 0; i < 4; ++i) { const int id = tid + 512 * i, t = id >> 4, lc = id & 15; const float* wp = A.sg_w + ((size_t)g * 128 + t) * 128 + lc * 8;
            f32x4 w0 = *(const f32x4*)wp, w1 = *(const f32x4*)(wp + 4);
#pragma unroll
            for (int e = 0; e < 4; ++e) { if (lc * 8 + e > t) w0[e] = 0.f; if (lc * 8 + 4 + e > t) w1[e] = 0.f; }
            u32x4 o; o.x = pk2(w0[0], w0[1]); o.y = pk2(w0[2], w0[3]); o.z = pk2(w1[0], w1[1]); o.w = pk2(w1[2], w1[3]);
            *(LAS u32x4*)(lds + t * 256 + ((lc ^ (t & 15)) << 4)) = o; }
#pragma unroll 2
        for (int i = 0; i < 8; ++i) { const int id = tid + 512 * i, s = id >> 5, lc = id & 31, ch = g * 256 + lc * 8;
            const u32x4 xv = *(const u32x4*)(PROJ + (size_t)(128 * n + s) * INW + C_VB + ch);
            const float mean = stats[2 * s], rstd = stats[2 * s + 1];
            const f32x4 g0 = *(const f32x4*)(A.sg_ln_g + ch), g1 = *(const f32x4*)(A.sg_ln_g + ch + 4), b0 = *(const f32x4*)(A.sg_ln_b + ch), b1 = *(const f32x4*)(A.sg_ln_b + ch + 4);
            u32x4 o;
            o.x = pk2((bf2f(xv.x & 0xffffu) - mean) * rstd * g0[0] + b0[0], (bf2f(xv.x >> 16) - mean) * rstd * g0[1] + b0[1]);
            o.y = pk2((bf2f(xv.y & 0xffffu) - mean) * rstd * g0[2] + b0[2], (bf2f(xv.y >> 16) - mean) * rstd * g0[3] + b0[3]);
            o.z = pk2((bf2f(xv.z & 0xffffu) - mean) * rstd * g1[0] + b1[0], (bf2f(xv.z >> 16) - mean) * rstd * g1[1] + b1[1]);
            o.w = pk2((bf2f(xv.w & 0xffffu) - mean) * rstd * g1[2] + b1[2], (bf2f(xv.w >> 16) - mean) * rstd * g1[3] + b1[3]);
            *(LAS u32x4*)(lds + 32768 + s * 512 + (((lc >> 2) ^ (s & 7)) << 6) + (lc & 3) * 16) = o; }
        __syncthreads();
        const int tb = wid & 3, dh = wid >> 2;
        f32x16 acc[4];
#pragma unroll
        for (int c = 0; c < 4; ++c)
#pragma unroll
            for (int r = 0; r < 16; ++r) acc[c][r] = 0.f;
        const int blk = (lane >> 4) & 1, q = (lane & 15) >> 2, p = lane & 3;
        const LAS unsigned char* ab = lds + (32 * tb + r32) * 256;
        const LAS unsigned char* vb = lds + 32768 + (8 * hh + q) * 512 + blk * 32 + p * 8;
        const int ns0 = 2 * tb + 2;
#pragma unroll 1
        for (int s0 = 0; s0 < ns0; ++s0) {
            const bf16x8 af = *(const LAS bf16x8*)(ab + (((2 * s0 + hh) ^ (r32 & 15)) << 4));
#pragma unroll
            for (int c4 = 0; c4 < 4; ++c4) { const int c = 4 * dh + c4;
                const s16x4 lo = trr(vb + s0 * 16 * 512 + ((c ^ q) << 6)), hi = trr(vb + s0 * 16 * 512 + 4 * 512 + ((c ^ (4 + q)) << 6));
                const bf16x8 vf = {lo[0], lo[1], lo[2], lo[3], hi[0], hi[1], hi[2], hi[3]};
                acc[c4] = __builtin_amdgcn_mfma_f32_32x32x16_bf16(af, vf, acc[c4], 0, 0, 0); }
        }
#pragma unroll
        for (int c4 = 0; c4 < 4; ++c4) { const int ch = g * 256 + 32 * (4 * dh + c4) + r32;
            const bf16_t* ub = PROJ + (size_t)(128 * n + 32 * tb + 4 * hh) * INW + ch; bf16_t* ob = AB + (size_t)(128 * n + 32 * tb + 4 * hh) * DM + ch;
            const float* bb = A.sg_b + g * 128 + 32 * tb + 4 * hh;
            unsigned uu[16], zz[16]; float bs[16];
#pragma unroll
            for (int r = 0; r < 16; ++r) { const int rr = (r & 3) + 8 * (r >> 2); uu[r] = ub[(size_t)rr * INW + C_UB]; zz[r] = ub[(size_t)rr * INW + C_ZB]; bs[r] = bb[rr]; }
#pragma unroll
            for (int r = 0; r < 16; ++r) { const int rr = (r & 3) + 8 * (r >> 2);
                ob[(size_t)rr * DM] = (bf16_t)(pk2(bf2f(uu[r]) * (acc[c4][r] + bs[r]) * bf2f(zz[r]), 0.f) & 0xffffu); }
            __builtin_amdgcn_sched_barrier(0);
        }
        __syncthreads();
    }
}

#define XB_TMO      128
#define XB_XCNT(j)  (256  + 64 * (j))
#define XB_XSUB(j)  (1280 + 64 * (j))
#define XB_XGEN(j)  (2304 + 64 * (j))
#define XB_TOP      3328
#define XB_TOPGEN   3392
#define XCD_BAR_WORDS 3456
#define XB_SPIN_CAP (1u << 18)

__device__ __forceinline__ unsigned xb_ld(unsigned* p)              { return __hip_atomic_load(p, __ATOMIC_RELAXED, __HIP_MEMORY_SCOPE_AGENT); }
__device__ __forceinline__ unsigned xb_add(unsigned* p, unsigned v) { return __hip_atomic_fetch_add(p, v, __ATOMIC_RELAXED, __HIP_MEMORY_SCOPE_AGENT); }
__device__ __forceinline__ unsigned xb_xcc_id() { return (unsigned)__builtin_amdgcn_s_getreg((3 << 11) | 20) & 0xFu; }
#define XB_SPIN(cond, bar) do { unsigned _sp = 0; while (cond) { __builtin_amdgcn_s_sleep(1); \
    if ((++_sp & 255u) == 0u) { if (xb_ld(&(bar)[XB_TMO])) break; if (_sp > XB_SPIN_CAP) { atomicAdd(&(bar)[XB_TMO], 1u); break; } } } } while (0)

struct XcdBarrier {
    unsigned* bar; unsigned x;
    volatile LAS unsigned* st;
};

__device__ __forceinline__ XcdBarrier xcd_barrier_post(unsigned* bar, volatile LAS unsigned* st) {
    XcdBarrier b; b.bar = bar; b.x = xb_xcc_id(); b.st = st;
    if (threadIdx.x == 0) (void)xb_add(&bar[XB_XCNT(b.x)], 1u);
    return b;
}
__device__ __forceinline__ void xcd_barrier_complete(unsigned* bar, unsigned x, unsigned& nloc, unsigned& nx) {
    const unsigned G = gridDim.x * gridDim.y * gridDim.z;
    unsigned sum, cnt, mine, sp = 0u;
    for (;;) {
        sum = 0u; cnt = 0u; mine = 0u;
#pragma unroll
        for (unsigned j = 0; j < 16; ++j) { const unsigned c = xb_ld(&bar[XB_XCNT(j)]); sum += c; cnt += (c > 0u) ? 1u : 0u; mine = (j == x) ? c : mine; }
        if (sum == G) break;
        __builtin_amdgcn_s_sleep(1);
        if ((++sp & 255u) == 0u) { if (xb_ld(&bar[XB_TMO])) break; if (sp > XB_SPIN_CAP) { atomicAdd(&bar[XB_TMO], 1u); break; } }
    }
    nloc = mine > 0u ? mine : 1u; nx = cnt > 0u ? cnt : 1u;
}

__device__ __forceinline__ void xcd_barrier(const XcdBarrier& b) {
    asm volatile("s_waitcnt vmcnt(0)" ::: "memory");
    __syncthreads();
    if (threadIdx.x == 0) {
        unsigned* bar = b.bar;
        __builtin_amdgcn_s_waitcnt(0);
        unsigned nloc = b.st[0], nx = b.st[1];
        if (nloc == 0u) { xcd_barrier_complete(bar, b.x, nloc, nx); b.st[0] = nloc; b.st[1] = nx; }
        const unsigned old = xb_add(&bar[XB_XSUB(b.x)], 1u);
        const unsigned gen = old / nloc;
        if (old + 1u == (gen + 1u) * nloc) {
            __builtin_amdgcn_fence(__ATOMIC_RELEASE, "agent");
            asm volatile("s_waitcnt vmcnt(0)" ::: "memory");
            const unsigned og = xb_add(&bar[XB_TOP], 1u);
            const unsigned tg = og / nx;
            if (og + 1u == (tg + 1u) * nx) xb_add(&bar[XB_TOPGEN], 1u);
            else XB_SPIN(xb_ld(&bar[XB_TOPGEN]) == tg, bar);
            __builtin_amdgcn_fence(__ATOMIC_ACQUIRE, "agent");
            xb_add(&bar[XB_XGEN(b.x)], 1u);
            asm volatile("s_waitcnt vmcnt(0)" ::: "memory");
        } else {
            XB_SPIN(xb_ld(&bar[XB_XGEN(b.x)]) == gen, bar);
            __builtin_amdgcn_fence(__ATOMIC_ACQUIRE, "agent");
            asm volatile("s_waitcnt vmcnt(0)" ::: "memory");
        }
    }
    __syncthreads();
}

#ifndef GEMM_ALIGN
#define GEMM_ALIGN true
#endif
#ifndef GEMM_SP2
#define GEMM_SP2 true
#endif
constexpr bool GA = GEMM_ALIGN, GS = GEMM_SP2;
constexpr int NPH = 9;
__global__ void __launch_bounds__(512) mega_fwd(Args A) {
    extern __shared__ __attribute__((aligned(16))) unsigned char lds_raw[];
    LAS unsigned char* lds = (LAS unsigned char*)lds_raw;
    const int tid = threadIdx.x, lane = tid & 63, wid = __builtin_amdgcn_readfirstlane(tid >> 6);
    const int G = gridDim.x, bx = blockIdx.x;
    const int lo = A.lo, hi = A.hi;
    unsigned char* ws = A.ws;
    if (tid < 4) ((volatile LAS unsigned*)(lds + XBST_OFF))[tid] = 0u;
    __syncthreads();
    const XcdBarrier xbar = xcd_barrier_post((unsigned*)(ws + WS_BAR), (volatile LAS unsigned*)(lds + XBST_OFF));
    bf16_t* PROJ = (bf16_t*)(ws + WS_PROJ);
#ifdef DOUBLE_SYNC
#define DBL_SYNC cooperative_groups::this_grid().sync(); cooperative_groups::this_grid().sync();
#else
#define DBL_SYNC
#endif
#define IN(k) (lo <= (k) && (k) < hi)
#define SEAM(k) do { if (IN(k) && IN((k) + 1)) { if ((k) == 0) { asm volatile("s_waitcnt vmcnt(0)" ::: "memory"); __syncthreads(); cooperative_groups::this_grid().sync(); DBL_SYNC } else xcd_barrier(xbar); } } while (0)

#ifndef REP_P0
#define REP_P0 1
#endif
#ifndef REP_P2
#define REP_P2 1
#endif
    if (IN(0)) for (int rep_ = 0; rep_ < REP_P0; ++rep_) {
        const int gw = bx * 8 + wid, NGW = G * 8;
        for (int i = bx * 512 + tid; i < 8192; i += G * 512) { ((float*)(ws + WS_RS))[i] = 0.f; ((float*)(ws + WS_RS2))[i] = 0.f; }
        if (bx == 0 && tid < 4) ((float*)(ws + WS_TMETA))[512 + tid] = 0.f;
        if (bx == 0 && tid < 128) { int mn = 0x7fffffff, mx = (int)0x80000000; for (int i = 0; i < 64; ++i) { const int v = A.pos[tid * 64 + i]; mn = v < mn ? v : mn; mx = v > mx ? v : mx; }
            ((int*)(ws + WS_TMETA))[tid] = mn; ((int*)(ws + WS_TMETA))[128 + tid] = mx; }
        LAS float* scr = (LAS float*)(lds + wid * 16384);
        constexpr int I_IN = 64 * (INW / 32), I_SQ = 64 * (DM / 32), I_XQ = 64 * (512 / 32), I_XKV = 64 * (1024 / 32), I_XO = 8 * (DM / 32);
        constexpr int NITEMS = I_IN + 3 * I_SQ + I_XQ + I_XKV + I_XO;
        for (int it = gw; it < NITEMS; it += NGW) {
            int r = it;
            if (r < I_IN) { p0_transpose_item(A.w_in, DM, INW, (bf16_t*)(ws + WS_WIN), scr, r, lane); continue; } r -= I_IN;
            if (r < I_SQ) { p0_transpose_item(A.w_pa, DM, DM, (bf16_t*)(ws + WS_WPA), scr, r, lane); continue; } r -= I_SQ;
            if (r < I_SQ) { p0_transpose_item(A.w_pb, DM, DM, (bf16_t*)(ws + WS_WPB), scr, r, lane); continue; } r -= I_SQ;
            if (r < I_SQ) { p0_transpose_item(A.w_out, DM, DM, (bf16_t*)(ws + WS_WOUT), scr, r, lane); continue; } r -= I_SQ;
            if (r < I_XQ) { p0_transpose_item(A.w_xq, DM, 512, (bf16_t*)(ws + WS_WXQ), scr, r, lane); continue; } r -= I_XQ;
            if (r < I_XKV) { p0_transpose_item(A.w_xkv, DM, 1024, (bf16_t*)(ws + WS_WXKV), scr, r, lane); continue; } r -= I_XKV;
            p0_transpose_item(A.w_xo, 512, DM, (bf16_t*)(ws + WS_WXO), scr, r, lane);
        }
        for (int m = gw; m < SEQ + MEML; m += NGW) {
            if (m < SEQ) rms_row_to_bf16(A.x + (size_t)m * DM, A.norm1_g, (bf16_t*)(ws + WS_HN) + (size_t)m * DM, lane);
            else rms_row_to_bf16(A.mem + (size_t)(m - SEQ) * DM, A.norm_mem_g, (bf16_t*)(ws + WS_MN) + (size_t)(m - SEQ) * DM, lane);
        }
        __syncthreads();
    }
    SEAM(0);
    if (IN(1)) {
        { pg8::Gemm g{(const bf16_t*)(ws + WS_HN), (const bf16_t*)(ws + WS_WIN), SEQ, INW, DM}; pg8::StaticOrder S; S.init(SEQ, INW, G, bx);
          pg8::EpiProj E{PROJ, INW, A.b_gate, QSCALE, 0};
          pg8::gemm_phase<pg8::EpiProj, pg8::StaticOrder, GA, GS>(lds, g, S, E); }
        if (bx < 64) { const int v = bx, ks = v >> 2;
            pg8::Gemm g{(const bf16_t*)(ws + WS_MN) + ks * 256, (const bf16_t*)(ws + WS_WXKV) + ks * 256, MEML, 1024, 256, DM}; pg8::StaticOrder S; S.init(MEML, 1024, 4, v & 3);
            pg8::EpiF32<false> E{(float*)(ws + WS_KVF) + (size_t)ks * MEML * 1024, 1024};
            pg8::gemm_phase<pg8::EpiF32<false>, pg8::StaticOrder, GA, GS>(lds, g, S, E); }
    }
    SEAM(1);
    if (IN(2)) for (int rep_ = 0; rep_ < REP_P2; ++rep_) {
        if (tid < 256) ((LAS int*)(lds + TM_OFF))[tid] = ((const int*)(ws + WS_TMETA))[tid];
        __syncthreads();
        float lam;
        { const float a = A.lq1[lane] * A.lk1[lane] + A.lq1[lane + 64] * A.lk1[lane + 64], b = A.lq2[lane] * A.lk2[lane] + A.lq2[lane + 64] * A.lk2[lane + 64];
          lam = expf(wave_sum(a)) - expf(wave_sum(b)) + 0.2f; }
        const int vcu = (G % 8 == 0) ? (bx % 8) * (G / 8) + bx / 8 : bx;
        for (int v = vcu; v < 256; v += G) {
            const int h = v >> 4, sx = v & 15;
#pragma unroll 1
            for (int i = 0; i < 8; ++i) { const int b16 = 16 * (i >> 1), qb = (i & 1) ? b16 + sx : 127 - b16 - sx;
#ifndef SKIP_DIFF
                diff_attn_unit(lds, A, h, qb, lam, tid, wid, lane);
#endif
            }
#ifndef SKIP_MIXB
            mixb_unit(lds, A, v >> 2, v & 3, tid, wid, lane);
#endif
        }
    }
#ifdef FILL_AB
    if (IN(2)) { const u32x4* src = (const u32x4*)(ws + WS_HN); u32x4* dst = (u32x4*)(ws + WS_AB);
        for (size_t i = (size_t)bx * 512 + tid; i < (size_t)SEQ * DM / 8; i += (size_t)G * 512) dst[i] = src[i]; }
#endif
    SEAM(2);
    if (IN(3)) {
        { pg8::Gemm g{(const bf16_t*)(ws + WS_AA), (const bf16_t*)(ws + WS_WPA), SEQ, DM, DM}; pg8::StaticOrder S; S.init(SEQ, DM, G, bx);
          pg8::EpiGateA E{PROJ + C_G, INW, (float*)(ws + WS_TMP), DM, A.b_gate};
          pg8::gemm_phase<pg8::EpiGateA, pg8::StaticOrder, GA, GS>(lds, g, S, E); }
#ifdef SYNC_P3
        cooperative_groups::this_grid().sync();
#endif
        { pg8::Gemm g{(const bf16_t*)(ws + WS_AB), (const bf16_t*)(ws + WS_WPB), SEQ, DM, DM}; pg8::StaticOrder S; S.init(SEQ, DM, G, bx);
          pg8::EpiGateB E{PROJ + C_G + DM, INW, (const float*)(ws + WS_TMP), DM, (bf16_t*)(ws + WS_MRG), DM, A.b_gate + DM};
          pg8::gemm_phase<pg8::EpiGateB, pg8::StaticOrder, GA, GS>(lds, g, S, E); }
    }
    SEAM(3);
    if (IN(4)) {
        pg8::Gemm g{(const bf16_t*)(ws + WS_MRG), (const bf16_t*)(ws + WS_WOUT), SEQ, DM, DM}; pg8::StaticOrder S; S.init(SEQ, DM, G, bx);
        pg8::EpiRes E{A.x, (float*)(ws + WS_H1), DM, A.norm_x_g, (bf16_t*)(ws + WS_HG), (float*)(ws + WS_RS)};
        pg8::gemm_phase<pg8::EpiRes, pg8::StaticOrder, GA, GS>(lds, g, S, E);
    }
    SEAM(4);
    if (IN(5)) {
        for (int i = bx * 512 + tid; i < MEML * 1024 / 2; i += G * 512) { float a = 0.f, b = 0.f;
#pragma unroll
            for (int ks = 0; ks < 16; ++ks) { a += ((const float*)(ws + WS_KVF))[(size_t)ks * MEML * 1024 + 2 * i]; b += ((const float*)(ws + WS_KVF))[(size_t)ks * MEML * 1024 + 2 * i + 1]; }
            ((unsigned*)(ws + WS_KVX))[i] = pk2(a, b); }
        if (bx < 256) { const int v = bx, ks = v >> 6;
            pg8::Gemm g{(const bf16_t*)(ws + WS_HG) + ks * 1024, (const bf16_t*)(ws + WS_WXQ) + ks * 1024, SEQ, 512, 1024, DM}; pg8::StaticOrder S; S.init(SEQ, 512, 64, v & 63);
            pg8::EpiF32<false> E{(float*)(ws + WS_TMP) + (size_t)ks * SEQ * 512, 512};
            pg8::gemm_phase<pg8::EpiF32<false>, pg8::StaticOrder, GA, GS>(lds, g, S, E); }
    }
    SEAM(5);
    if (IN(6)) {
#ifndef SKIP_CROSS
        for (int v = bx; v < 128; v += G) cross_attn_unit(lds, A, v & 3, v >> 2, tid, wid, lane);
#endif
    }
    SEAM(6);
    if (IN(7)) {
        pg8::Gemm g{(const bf16_t*)(ws + WS_OX), (const bf16_t*)(ws + WS_WXO), SEQ, DM, 512}; pg8::StaticOrder S; S.init(SEQ, DM, G, bx);
        pg8::EpiRes E{(const float*)(ws + WS_H1), A.out, DM, A.final_g, nullptr, (float*)(ws + WS_RS2)};
        pg8::gemm_phase<pg8::EpiRes, pg8::StaticOrder, GA, GS>(lds, g, S, E);
    }
    SEAM(7);
#ifdef DBG_STAT
    if (IN(8)) {
        const bf16_t* base = PROJ; int cols = 4096, pitch = INW; const float* fa = nullptr; const float* fb = nullptr;
        if (DBG_STAT == 1) { base = PROJ + C_ZA; }
        else if (DBG_STAT == 2) { base = (const bf16_t*)(ws + WS_AA); pitch = DM; }
        else if (DBG_STAT == 3) { base = (const bf16_t*)(ws + WS_AB); pitch = DM; }
        else if (DBG_STAT == 4) { base = PROJ + C_Q; }
        else if (DBG_STAT == 5) { base = PROJ + C_G; cols = 8192; }
        else if (DBG_STAT == 6) { base = PROJ + C_UB; }
        else if (DBG_STAT == 7) { base = PROJ + C_V; }
        else if (DBG_STAT == 8) { base = PROJ + C_VB; }
        else if (DBG_STAT == 9) { base = PROJ + C_K; }
        else if (DBG_STAT == 10) { base = (const bf16_t*)(ws + WS_MRG); pitch = DM; }
        else if (DBG_STAT == 11) { base = (const bf16_t*)(ws + WS_HG); pitch = DM; }
        else if (DBG_STAT == 12) { base = (const bf16_t*)(ws + WS_QX); cols = 512; pitch = 512; }
        else if (DBG_STAT == 14) { base = (const bf16_t*)(ws + WS_OX); cols = 512; pitch = 512; }
        else if (DBG_STAT == 15) { fa = A.out; fb = (const float*)(ws + WS_H1); }
        else if (DBG_STAT == 16) { fa = (const float*)(ws + WS_H1); fb = A.x; }
        float acc = 0.f;
        if (DBG_STAT == 30 || DBG_STAT == 31) {
            const int sid = bx * 8 + wid; const unsigned hsh = (unsigned)(sid + 1) * 2654435761u;
            float num = 0.f, den = 0.f;
            if (DBG_STAT == 30) {
                const int r = (int)((hsh >> 7) % (unsigned)SEQ), h = (int)((hsh >> 3) & 15u);
                float lam_; { const float a = A.lq1[lane] * A.lk1[lane] + A.lq1[lane + 64] * A.lk1[lane + 64], b = A.lq2[lane] * A.lk2[lane] + A.lq2[lane + 64] * A.lk2[lane + 64];
                    lam_ = expf(wave_sum(a)) - expf(wave_sum(b)) + 0.2f; }
                const bf16_t* qp = PROJ + (size_t)r * INW + C_Q + h * 256;
                const float q10 = bf2f(qp[2 * lane]), q11 = bf2f(qp[2 * lane + 1]), q20 = bf2f(qp[128 + 2 * lane]), q21 = bf2f(qp[128 + 2 * lane + 1]);
                float m1 = -1e30f, m2 = -1e30f, l1 = 0.f, l2 = 0.f, a1[4] = {0.f, 0.f, 0.f, 0.f}, a2[4] = {0.f, 0.f, 0.f, 0.f};
                const int pr = A.pos[r];
                for (int j = 0; j < SEQ; ++j) {
                    const int rel = pr - A.pos[j]; if (rel < 0) continue;
                    const bf16_t* kp = PROJ + (size_t)j * INW + C_K + h * 256; const bf16_t* vp = PROJ + (size_t)j * INW + C_V + h * 256 + 4 * lane;
                    float s1 = wave_sum(q10 * bf2f(kp[2 * lane]) + q11 * bf2f(kp[2 * lane + 1])), s2 = wave_sum(q20 * bf2f(kp[128 + 2 * lane]) + q21 * bf2f(kp[128 + 2 * lane + 1]));
                    int bkt; if (rel < 16) bkt = rel; else { const float nf = (float)rel; bkt = 16 + (int)(logf(nf / 16.f) / 2.0794415416798357f * 16.f); bkt = bkt > 31 ? 31 : bkt; }
                    const float bias = A.rel_bias[bkt * 16 + h] * LOG2E; s1 += bias; s2 += bias;
                    const float v0 = bf2f(vp[0]), v1 = bf2f(vp[1]), v2 = bf2f(vp[2]), v3 = bf2f(vp[3]);
                    { const float mn = fmaxf(m1, s1), al = exp2f(m1 - mn), p = exp2f(s1 - mn); l1 = l1 * al + p; a1[0] = a1[0] * al + p * v0; a1[1] = a1[1] * al + p * v1; a1[2] = a1[2] * al + p * v2; a1[3] = a1[3] * al + p * v3; m1 = mn; }
                    { const float mn = fmaxf(m2, s2), al = exp2f(m2 - mn), p = exp2f(s2 - mn); l2 = l2 * al + p; a2[0] = a2[0] * al + p * v0; a2[1] = a2[1] * al + p * v1; a2[2] = a2[2] * al + p * v2; a2[3] = a2[3] * al + p * v3; m2 = mn; }
                }
                float o[4], ssq = 0.f;
                for (int e = 0; e < 4; ++e) { o[e] = a1[e] / l1 - lam_ * a2[e] / l2; ssq += o[e] * o[e]; }
                const float rstd = rsqrtf(wave_sum(ssq) * (1.f / 256.f) + EPS) * 0.8f;
                for (int e = 0; e < 4; ++e) { const int d = 4 * lane + e; const float ex = o[e] * rstd * A.subln_g[d] * bf2f(PROJ[(size_t)r * INW + C_ZA + h * 256 + d]);
                    const float st = bf2f(((const bf16_t*)(ws + WS_AA))[(size_t)r * DM + h * 256 + d]); num += fabsf(ex - st); den += fabsf(ex); }
            } else {
                const int tok = (int)((hsh >> 7) % (unsigned)SEQ), g = (int)((hsh >> 3) & 15u), n = tok >> 7, t = tok & 127;
                float mx[4] = {0.f, 0.f, 0.f, 0.f};
                for (int s_ = 0; s_ <= t; ++s_) { const bf16_t* rowp = PROJ + (size_t)(128 * n + s_) * INW + C_VB; float sm = 0.f, sq = 0.f;
                    for (int e = 0; e < 64; ++e) { const float v = bf2f(rowp[lane + 64 * e]); sm += v; sq += v * v; }
                    const float mean = wave_sum(sm) * (1.f / 4096.f), var = wave_sum(sq) * (1.f / 4096.f) - mean * mean, rstd = rsqrtf(var + EPS);
                    const float w = A.sg_w[((size_t)g * 128 + t) * 128 + s_];
                    for (int e = 0; e < 4; ++e) { const int ch = g * 256 + 4 * lane + e; mx[e] += w * ((bf2f(rowp[ch]) - mean) * rstd * A.sg_ln_g[ch] + A.sg_ln_b[ch]); } }
                for (int e = 0; e < 4; ++e) { const int ch = g * 256 + 4 * lane + e; const float ex = bf2f(PROJ[(size_t)tok * INW + C_UB + ch]) * (mx[e] + A.sg_b[g * 128 + t]) * bf2f(PROJ[(size_t)tok * INW + C_ZB + ch]);
                    const float st = bf2f(((const bf16_t*)(ws + WS_AB))[(size_t)tok * DM + ch]); num += fabsf(ex - st); den += fabsf(ex); }
            }
            num = wave_sum(num); den = wave_sum(den);
            if (lane == 0) { atomicAdd((float*)(ws + WS_TMETA) + 513, num); atomicAdd((float*)(ws + WS_TMETA) + 514, den); }
            asm volatile("s_waitcnt vmcnt(0)" ::: "memory"); __syncthreads(); cooperative_groups::this_grid().sync();
            if (bx == 0 && tid == 0) { const float n_ = __hip_atomic_load((float*)(ws + WS_TMETA) + 513, __ATOMIC_RELAXED, __HIP_MEMORY_SCOPE_AGENT), d_ = __hip_atomic_load((float*)(ws + WS_TMETA) + 514, __ATOMIC_RELAXED, __HIP_MEMORY_SCOPE_AGENT);
                atomicAdd((float*)(ws + WS_TMETA) + 512, n_ / d_); }
        } else
        if ((DBG_STAT >= 20 && DBG_STAT < 30) || (DBG_STAT >= 33 && DBG_STAT <= 35)) {
            const int sid = bx * 512 + tid; const unsigned hsh = (unsigned)(sid + 1) * 2654435761u;
            int r = (int)((hsh >> 8) % (unsigned)SEQ); float dot = 0.f, st = 0.f;
            if (DBG_STAT <= 24) {
                const int csec = (DBG_STAT == 20) ? C_V : (DBG_STAT == 21) ? C_K : (DBG_STAT == 22) ? C_Q : (DBG_STAT == 23) ? C_UB : C_G;
                const int c = csec + (int)((hsh >> 3) % (DBG_STAT == 24 ? 8192u : 4096u));
                const bf16_t* hn = (const bf16_t*)(ws + WS_HN) + (size_t)r * DM;
                for (int k = 0; k < DM; ++k) dot += bf2f(hn[k]) * A.w_in[(size_t)k * INW + c];
                if (DBG_STAT == 22) dot *= QSCALE;
                if (DBG_STAT == 23) dot = pg8::gelut_(dot);
                st = bf2f(PROJ[(size_t)r * INW + c]);
            } else if (DBG_STAT == 25) {
                const int c = (int)((hsh >> 3) % 4096u); const bf16_t* aa = (const bf16_t*)(ws + WS_AA) + (size_t)r * DM; const bf16_t* ab = (const bf16_t*)(ws + WS_AB) + (size_t)r * DM;
                float ya = 0.f, yb = 0.f;
                for (int k = 0; k < DM; ++k) { ya += bf2f(aa[k]) * A.w_pa[(size_t)k * DM + c]; yb += bf2f(ab[k]) * A.w_pb[(size_t)k * DM + c]; }
                dot = ya / (1.f + expf(-(bf2f(PROJ[(size_t)r * INW + C_G + c]) + A.b_gate[c]))) + yb / (1.f + expf(-(bf2f(PROJ[(size_t)r * INW + C_G + DM + c]) + A.b_gate[DM + c])));
                st = bf2f(((const bf16_t*)(ws + WS_MRG))[(size_t)r * DM + c]);
            } else if (DBG_STAT == 26) {
                const int c = (int)((hsh >> 3) % 4096u); const bf16_t* mg = (const bf16_t*)(ws + WS_MRG) + (size_t)r * DM;
                for (int k = 0; k < DM; ++k) dot += bf2f(mg[k]) * A.w_out[(size_t)k * DM + c];
                st = ((const float*)(ws + WS_H1))[(size_t)r * DM + c] - A.x[(size_t)r * DM + c];
            } else if (DBG_STAT == 27) {
                const int c = (int)((hsh >> 3) % 512u); const float* h1 = (const float*)(ws + WS_H1) + (size_t)r * DM; float ssq = 0.f;
                for (int k = 0; k < DM; ++k) { ssq += h1[k] * h1[k]; dot += h1[k] * A.norm_x_g[k] * A.w_xq[(size_t)k * 512 + c]; }
                dot *= rsqrtf(ssq * (1.f / 4096.f) + EPS) * QSCALE;
                st = bf2f(((const bf16_t*)(ws + WS_QX))[(size_t)r * 512 + c]);
            } else if (DBG_STAT == 28) {
                const int c = (int)((hsh >> 3) % 512u), h = c >> 7; const bf16_t* qx = (const bf16_t*)(ws + WS_QX) + (size_t)r * 512 + h * 128; const bf16_t* kv = (const bf16_t*)(ws + WS_KVX);
                float m = -1e30f, l = 0.f, ac = 0.f;
                for (int j = 0; j < MEML; ++j) { float sc = 0.f; for (int k = 0; k < 128; ++k) sc += bf2f(qx[k]) * bf2f(kv[(size_t)j * 1024 + h * 128 + k]);
                    const float mn = fmaxf(m, sc), al = exp2f(m - mn), p = exp2f(sc - mn); l = l * al + p; ac = ac * al + p * bf2f(kv[(size_t)j * 1024 + 512 + c]); m = mn; }
                dot = ac / l; st = bf2f(((const bf16_t*)(ws + WS_OX))[(size_t)r * 512 + c]);
            } else if (DBG_STAT == 29) {
                const int c = (int)((hsh >> 3) % 4096u); const bf16_t* ox = (const bf16_t*)(ws + WS_OX) + (size_t)r * 512;
                for (int k = 0; k < 512; ++k) dot += bf2f(ox[k]) * A.w_xo[(size_t)k * DM + c];
                dot += ((const float*)(ws + WS_H1))[(size_t)r * DM + c]; st = A.out[(size_t)r * DM + c];
            } else if (DBG_STAT == 34 || DBG_STAT == 35) {
                const float* hp = (DBG_STAT == 34) ? A.out + (size_t)r * DM : (const float*)(ws + WS_H1) + (size_t)r * DM;
                for (int k = 0; k < DM; ++k) dot += hp[k] * hp[k];
                st = ((const float*)(ws + (DBG_STAT == 34 ? WS_RS2 : WS_RS)))[r];
#ifdef DBG_HALF
                st *= 0.5f;
#endif
            } else {
                r = r % MEML; const int c = (int)((hsh >> 3) % 1024u); const bf16_t* mn_ = (const bf16_t*)(ws + WS_MN) + (size_t)r * DM;
                for (int k = 0; k < DM; ++k) dot += bf2f(mn_[k]) * A.w_xkv[(size_t)k * 1024 + c];
                st = bf2f(((const bf16_t*)(ws + WS_KVX))[(size_t)r * 1024 + c]);
            }
            float num = wave_sum(fabsf(dot - st)), den = wave_sum(fabsf(dot));
            if (lane == 0) { atomicAdd((float*)(ws + WS_TMETA) + 513, num); atomicAdd((float*)(ws + WS_TMETA) + 514, den); }
            asm volatile("s_waitcnt vmcnt(0)" ::: "memory"); __syncthreads(); cooperative_groups::this_grid().sync();
            if (bx == 0 && tid == 0) { const float n_ = __hip_atomic_load((float*)(ws + WS_TMETA) + 513, __ATOMIC_RELAXED, __HIP_MEMORY_SCOPE_AGENT), d_ = __hip_atomic_load((float*)(ws + WS_TMETA) + 514, __ATOMIC_RELAXED, __HIP_MEMORY_SCOPE_AGENT);
                atomicAdd((float*)(ws + WS_TMETA) + 512, n_ / d_); }
        } else
        if (fa) { for (int r = bx; r < SEQ; r += G) for (int c = tid; c < DM; c += 512) acc += fabsf(fa[(size_t)r * DM + c] - fb[(size_t)r * DM + c]); cols = DM; }
        else { for (int r = bx; r < SEQ; r += G) for (int c = tid; c < cols; c += 512) acc += fabsf(bf2f(base[(size_t)r * pitch + c])); }
        acc = wave_sum(acc);
        if (lane == 0) atomicAdd((float*)(ws + WS_TMETA) + 512, acc / ((float)SEQ * (float)cols));
        asm volatile("s_waitcnt vmcnt(0)" ::: "memory"); __syncthreads(); cooperative_groups::this_grid().sync();
        const int gw = bx * 8 + wid, NGW = G * 8; const float sv = ((const float*)(ws + WS_TMETA))[512];
        const float cc = 1.f + 2.f * fminf(fmaxf(sv, 0.f), 1.f);
        for (int m = gw; m < SEQ; m += NGW) {
            const f32x4* xr = (const f32x4*)(A.x + (size_t)m * DM) + lane; f32x4* o = (f32x4*)(A.out + (size_t)m * DM) + lane; const f32x4* gr = (const f32x4*)A.final_g + lane;
            float ssq = 0.f;
            for (int j = 0; j < 16; ++j) { const f32x4 v = xr[64 * j]; ssq += v.x * v.x + v.y * v.y + v.z * v.z + v.w * v.w; }
            const float rs = rsqrtf(wave_sum(ssq) * (1.f / 4096.f) + EPS) * cc;
            for (int j = 0; j < 16; ++j) { o[64 * j] = xr[64 * j] * rs * gr[64 * j]; }
        }
    }
    return;
#endif
    if (IN(8)) {
        const int gw = bx * 8 + wid, NGW = G * 8; const float* RS2 = (const float*)(ws + WS_RS2);
        for (int m = gw; m < SEQ; m += NGW) { const float rs = rsqrtf(RS2[m] * (1.f / 4096.f) + EPS);
            f32x4* o = (f32x4*)(A.out + (size_t)m * DM) + lane; const f32x4* gr = (const f32x4*)A.final_g + lane;
#pragma unroll 4
            for (int j = 0; j < 16; ++j) { f32x4 v = o[64 * j]; const f32x4 gg = gr[64 * j]; v = v * rs * gg; o[64 * j] = v; } }
    }
#undef IN
#undef SEAM
}

#ifndef MK_MULTI
#define MK_MULTI 0
#endif
extern "C" void kernel_launch(void* const* d_in, const int* in_sizes, int n_in, void* d_out, int out_size, void* d_ws, size_t ws_size, hipStream_t stream) {
    static int grid = 0;
    if (grid == 0) {
        if (n_in != 25 || ws_size < WS_END) { fprintf(stderr, "kernel_launch: unexpected n_in %d / ws %zu (need %zu)\n", n_in, ws_size, (size_t)WS_END); grid = -1; return; }
        int dev = 0, cus = 0, per_cu = 0;
        hipGetDevice(&dev); hipDeviceGetAttribute(&cus, hipDeviceAttributeMultiprocessorCount, dev);
        if (hipFuncSetAttribute((const void*)mega_fwd, hipFuncAttributeMaxDynamicSharedMemorySize, LDS_BYTES) != hipSuccess) { fprintf(stderr, "kernel_launch: hipFuncSetAttribute failed\n"); grid = -1; return; }
        hipOccupancyMaxActiveBlocksPerMultiprocessor(&per_cu, (const void*)mega_fwd, 512, LDS_BYTES);
        if (per_cu < 1) per_cu = 1;
        (void)hipGetLastError();
        grid = cus * 1;
        if (grid < 256) { fprintf(stderr, "kernel_launch: this kernel needs >= 256 CUs (got %d)\n", grid); grid = -1; return; }
    }
    if (grid < 0) return;
    Args a{};
    a.x = (const float*)d_in[0]; a.pos = (const int*)d_in[1]; a.mem = (const float*)d_in[2]; a.w_in = (const float*)d_in[3]; a.b_gate = (const float*)d_in[4];
    a.norm1_g = (const float*)d_in[5]; a.lq1 = (const float*)d_in[6]; a.lk1 = (const float*)d_in[7]; a.lq2 = (const float*)d_in[8]; a.lk2 = (const float*)d_in[9];
    a.subln_g = (const float*)d_in[10]; a.rel_bias = (const float*)d_in[11]; a.sg_ln_g = (const float*)d_in[12]; a.sg_ln_b = (const float*)d_in[13];
    a.sg_w = (const float*)d_in[14]; a.sg_b = (const float*)d_in[15]; a.w_pa = (const float*)d_in[16]; a.w_pb = (const float*)d_in[17]; a.w_out = (const float*)d_in[18];
    a.norm_x_g = (const float*)d_in[19]; a.norm_mem_g = (const float*)d_in[20]; a.w_xq = (const float*)d_in[21]; a.w_xkv = (const float*)d_in[22]; a.w_xo = (const float*)d_in[23];
    a.final_g = (const float*)d_in[24];
    a.out = (float*)d_out; a.ws = (unsigned char*)d_ws;
#if MK_MULTI
    for (int ph = 0; ph < NPH; ++ph) { a.lo = ph; a.hi = ph + 1; hipLaunchKernelGGL(mega_fwd, dim3(grid), dim3(512), LDS_BYTES, stream, a); }
#else
    a.lo = 0; a.hi = NPH;
    (void)hipMemsetAsync((char*)d_ws + WS_BAR, 0, BAR_BYTES, stream);
    void* args[] = {&a};
    hipError_t e = hipLaunchCooperativeKernel((const void*)mega_fwd, dim3(grid), dim3(512), args, LDS_BYTES, stream);
    if (e != hipSuccess) fprintf(stderr, "cooperative launch failed: %s (grid %d)\n", hipGetErrorString(e), grid);
#endif
}
```
